# Optimizing an MI355X kernel written in HIP

```python
import jax, jax.numpy as jnp
from jax import lax
import numpy as np

D_MODEL = 1024
BATCH = 4
SEQ = 4096
DEPTH = 1

GRID_W = 64
CTX_LEN = 256
RET_HEADS = 4
RET_QK = 128
RET_V = 256
RET_CHUNK = 128
RET_ROPE_BASE = 10000.0
MLA_HEADS = 8
MLA_NOPE = 64
MLA_ROPE = 32
MLA_V = 64
MLA_Q_RANK = 384
MLA_KV_RANK = 256
ROPE_BASE = 10000.0
Q_BLOCK = 128
D_FF = -(-8 * D_MODEL // (3 * 256)) * 256
IN_SPLITS = (RET_HEADS * RET_QK, RET_HEADS * RET_QK, RET_HEADS * RET_V, RET_HEADS * RET_V,
             MLA_Q_RANK, MLA_KV_RANK, MLA_ROPE, D_MODEL, D_MODEL)
IN_WIDTH = sum(IN_SPLITS)
LN_EPS = 1e-5
RMS_EPS = 1e-6

kernel_name = 'hybrid_retention_mla_prefix_dit_block'


def _layer_norm(x, g, b):
    xf = x.astype(jnp.float32)
    xc = xf - jnp.mean(xf, -1, keepdims=True)
    var = jnp.mean(xc * xc, -1, keepdims=True)
    return (xc * lax.rsqrt(var + LN_EPS) * g + b).astype(x.dtype)


def _rms_norm(x, g):
    xf = x.astype(jnp.float32)
    return (xf * lax.rsqrt(jnp.mean(xf * xf, -1, keepdims=True) + RMS_EPS) * g).astype(x.dtype)


def _head_norm(x):
    xf = x.astype(jnp.float32)
    xc = xf - jnp.mean(xf, -1, keepdims=True)
    var = jnp.mean(xc * xc, -1, keepdims=True)
    return (xc * lax.rsqrt(var + LN_EPS)).astype(x.dtype)


def _rope(x, pos, base):
    d = x.shape[-1]
    half = d // 2
    freqs = base ** (-jnp.arange(half, dtype=jnp.float32) / half)
    ang = pos[:, None] * freqs[None, :]
    cos = jnp.cos(ang)[None, :, None, :]
    sin = jnp.sin(ang)[None, :, None, :]
    xf = x.astype(jnp.float32)
    x1, x2 = xf[..., :half], xf[..., half:]
    return jnp.concatenate([x1 * cos - x2 * sin, x2 * cos + x1 * sin], -1).astype(x.dtype)


def _rope_2d(x, row, col):
    h = x.shape[-1] // 2
    return jnp.concatenate([_rope(x[..., :h], row, ROPE_BASE), _rope(x[..., h:], col, ROPE_BASE)], -1)


def _split_in(p):
    bounds = []
    acc = 0
    for w in IN_SPLITS[:-1]:
        acc += w
        bounds.append(acc)
    return jnp.split(p, bounds, axis=-1)


def _heads(a, n):
    return a.reshape(a.shape[0], a.shape[1], n, a.shape[-1] // n)


def _retention_dir(q, k, v, log_g, s0):
    B, L, H, _ = q.shape
    dv = v.shape[-1]
    C = RET_CHUNK
    N = L // C

    def chunks(a):
        return a.astype(jnp.float32).reshape(B, N, C, H, a.shape[-1]).transpose(1, 0, 3, 2, 4)

    idx = jnp.arange(C, dtype=jnp.float32)
    rel = idx[:, None] - idx[None, :]
    inner = jnp.where(rel[None] >= 0, jnp.exp(jnp.maximum(rel, 0.0)[None] * log_g[:, None, None]), 0.0)
    q_dec = jnp.exp((idx + 1.0)[None, :] * log_g[:, None])[None, :, :, None]
    k_dec = jnp.exp((C - 1.0 - idx)[None, :] * log_g[:, None])[None, :, :, None]
    c_dec = jnp.exp(C * log_g)[None, :, None, None]

    def step(s, blk):
        qc, kc, vc = blk
        a = jnp.einsum('bhid,bhjd->bhij', qc, kc) * inner
        o = jnp.einsum('bhij,bhjv->bhiv', a, vc) + jnp.einsum('bhid,bhdv->bhiv', qc, s) * q_dec
        s = s * c_dec + jnp.einsum('bhjd,bhjv->bhdv', kc * k_dec, vc)
        return s, o

    s, o = lax.scan(step, s0, (chunks(q), chunks(k), chunks(v)))
    out = o.transpose(1, 0, 3, 2, 4).reshape(B, L, H, dv)
    return out.astype(v.dtype), s


def _attend(q, k, v):
    s = jnp.einsum('bqhd,bkhd->bhqk', q, k).astype(jnp.float32) * (q.shape[-1] ** -0.5)
    p = jax.nn.softmax(s, axis=-1).astype(v.dtype)
    return jnp.einsum('bhqk,bkhv->bqhv', p, v)


def _blocked_attend(q, k, v):
    B, L, H, d = q.shape
    nb = L // Q_BLOCK
    qb = q.reshape(B, nb, Q_BLOCK, H, d).transpose(1, 0, 2, 3, 4)
    ob = lax.map(lambda qi: _attend(qi, k, v), qb)
    return ob.transpose(1, 0, 2, 3, 4).reshape(B, L, H, ob.shape[-1])


def _mla_qkv(dq, dkv, kr, q_norm, w_uq, kv_norm, w_ukv, pos2d):
    B, L = dq.shape[0], dq.shape[1]
    q = _heads(_rms_norm(dq, q_norm) @ w_uq, MLA_HEADS)
    kv = _heads(_rms_norm(dkv, kv_norm) @ w_ukv, MLA_HEADS)
    q_nope, q_rope = q[..., :MLA_NOPE], q[..., MLA_NOPE:]
    k_nope, v = kv[..., :MLA_NOPE], kv[..., MLA_NOPE:]
    k_rope = kr[:, :, None, :]
    if pos2d is not None:
        q_rope = _rope_2d(q_rope, pos2d[0], pos2d[1])
        k_rope = _rope_2d(k_rope, pos2d[0], pos2d[1])
    k_rope = jnp.broadcast_to(k_rope, (B, L, MLA_HEADS, MLA_ROPE))
    return (jnp.concatenate([q_nope, q_rope], -1), jnp.concatenate([k_nope, k_rope], -1), v)


def _swiglu(h, w_gu, w_down):
    a, b = jnp.split(h @ w_gu, 2, axis=-1)
    return (jax.nn.silu(a) * b) @ w_down


def _token_mixer(hc, hl, row, col, tpos, w_in, dec_f, dec_b, w_ret_o, q_norm, w_uq, kv_norm, w_ukv,
                 w_mla_o, w_out, need_ctx):
    B, L, _ = hl.shape
    rq_c, rk_c, rv_c, rg_c, dq_c, dkv_c, kr_c, gr_c, gm_c = _split_in(hc @ w_in)
    rq_l, rk_l, rv_l, rg_l, dq_l, dkv_l, kr_l, gr_l, gm_l = _split_in(hl @ w_in)

    k_scale = RET_QK ** -0.5
    qc = _heads(rq_c, RET_HEADS)
    kc = _heads(rk_c, RET_HEADS) * k_scale
    vc = _heads(rv_c, RET_HEADS)
    ql = _rope(_heads(rq_l, RET_HEADS), tpos, RET_ROPE_BASE)
    kl = _rope(_heads(rk_l, RET_HEADS), tpos, RET_ROPE_BASE) * k_scale
    vl = _heads(rv_l, RET_HEADS)
    lg_f = jax.nn.log_sigmoid(dec_f.astype(jnp.float32))
    lg_b = jax.nn.log_sigmoid(dec_b.astype(jnp.float32))
    s0 = jnp.zeros((B, RET_HEADS, RET_QK, RET_V), jnp.float32)
    flip = lambda a: jnp.flip(a, axis=1)
    oc_f, s_f = _retention_dir(qc, kc, vc, lg_f, s0)
    oc_b, s_b = _retention_dir(flip(qc), flip(kc), flip(vc), lg_b, s0)
    ol_f, _ = _retention_dir(ql, kl, vl, lg_f, s_f)
    ol_b, _ = _retention_dir(flip(ql), flip(kl), flip(vl), lg_b, s_b)
    ret_l = (jax.nn.silu(rg_l) * _head_norm(ol_f + flip(ol_b)).reshape(B, L, -1)) @ w_ret_o

    q_c, k_c, v_c = _mla_qkv(dq_c, dkv_c, kr_c, q_norm, w_uq, kv_norm, w_ukv, None)
    q_l, k_l, v_l = _mla_qkv(dq_l, dkv_l, kr_l, q_norm, w_uq, kv_norm, w_ukv, (row, col))
    k_all = jnp.concatenate([k_c, k_l], axis=1)
    v_all = jnp.concatenate([v_c, v_l], axis=1)
    mla_l = _blocked_attend(q_l, k_all, v_all).reshape(B, L, -1) @ w_mla_o

    y_l = (jax.nn.sigmoid(gr_l) * ret_l + jax.nn.sigmoid(gm_l) * mla_l) @ w_out

    y_c = None
    if need_ctx:
        Lc = hc.shape[1]
        ret_c = (jax.nn.silu(rg_c) * _head_norm(oc_f + flip(oc_b)).reshape(B, Lc, -1)) @ w_ret_o
        mla_c = _attend(q_c, k_c, v_c).reshape(B, Lc, -1) @ w_mla_o
        y_c = (jax.nn.sigmoid(gr_c) * ret_c + jax.nn.sigmoid(gm_c) * mla_c) @ w_out
    return y_c, y_l


def setup_inputs(seed: int = 0) -> dict:
    key = jax.random.key(seed)
    ks = jax.random.split(key, 22)
    f32 = jnp.float32
    beta = (8.0 * DEPTH) ** -0.25

    def nrm(k, shape, scale):
        return jax.random.normal(k, shape, f32) * scale

    dec0 = jnp.log(jnp.exp2(5.0 + jnp.arange(RET_HEADS, dtype=f32)) - 1.0)
    return {
        'x': nrm(ks[0], (BATCH, SEQ, D_MODEL), 1.0),
        'c': nrm(ks[1], (BATCH, D_MODEL), 1.0),
        'ctx': nrm(ks[2], (BATCH, CTX_LEN, D_MODEL), 1.0),
        'c_ctx': nrm(ks[3], (D_MODEL,), 1.0),
        'w_ada': nrm(ks[4], (DEPTH, D_MODEL, 6 * D_MODEL), D_MODEL ** -0.5),
        'b_ada': nrm(ks[5], (DEPTH, 6 * D_MODEL), 0.02),
        'w_in': nrm(ks[6], (DEPTH, D_MODEL, IN_WIDTH), D_MODEL ** -0.5),
        'ret_decay_f': dec0 + nrm(ks[7], (DEPTH, RET_HEADS), 0.1),
        'ret_decay_b': dec0 + nrm(ks[8], (DEPTH, RET_HEADS), 0.1),
        'w_ret_o': nrm(ks[9], (DEPTH, RET_HEADS * RET_V, D_MODEL), beta * (RET_HEADS * RET_V) ** -0.5),
        'mla_q_norm': 1.0 + nrm(ks[10], (DEPTH, MLA_Q_RANK), 0.02),
        'w_uq': nrm(ks[11], (DEPTH, MLA_Q_RANK, MLA_HEADS * (MLA_NOPE + MLA_ROPE)), MLA_Q_RANK ** -0.5),
        'mla_kv_norm': 1.0 + nrm(ks[12], (DEPTH, MLA_KV_RANK), 0.02),
        'w_ukv': nrm(ks[13], (DEPTH, MLA_KV_RANK, MLA_HEADS * (MLA_NOPE + MLA_V)), MLA_KV_RANK ** -0.5),
        'w_mla_o': nrm(ks[14], (DEPTH, MLA_HEADS * MLA_V, D_MODEL), beta * (MLA_HEADS * MLA_V) ** -0.5),
        'w_out': nrm(ks[15], (DEPTH, D_MODEL, D_MODEL), beta * D_MODEL ** -0.5),
        'ln1_g': 1.0 + nrm(ks[16], (DEPTH, D_MODEL), 0.02),
        'ln1_b': nrm(ks[17], (DEPTH, D_MODEL), 0.02),
        'w_gu': nrm(ks[18], (DEPTH, D_MODEL, 2 * D_FF), D_MODEL ** -0.5),
        'w_down': nrm(ks[19], (DEPTH, D_FF, D_MODEL), beta * D_FF ** -0.5),
        'ln2_g': 1.0 + nrm(ks[20], (DEPTH, D_MODEL), 0.02),
        'ln2_b': nrm(ks[21], (DEPTH, D_MODEL), 0.02),
    }


def reference(x, c, ctx, c_ctx, w_ada, b_ada, w_in, ret_decay_f, ret_decay_b, w_ret_o, mla_q_norm, w_uq,
              mla_kv_norm, w_ukv, w_mla_o, w_out, ln1_g, ln1_b, w_gu, w_down, ln2_g, ln2_b):
    L = x.shape[1]
    rows = L // GRID_W
    row = jnp.repeat(jnp.arange(rows, dtype=jnp.float32), GRID_W)
    col = jnp.tile(jnp.arange(GRID_W, dtype=jnp.float32), rows)
    tpos = jnp.arange(L, dtype=jnp.float32)
    alpha = (2.0 * DEPTH) ** 0.25
    sc = jax.nn.silu(c)
    scc = jax.nn.silu(c_ctx)
    for i in range(DEPTH):
        last = i == DEPTH - 1
        sh1, s1, g1, sh2, s2, g2 = jnp.split((sc @ w_ada[i] + b_ada[i])[:, None, :], 6, axis=-1)
        csh1, cs1, cg1, csh2, cs2, cg2 = jnp.split(scc @ w_ada[i] + b_ada[i], 6, axis=-1)
        hl = x * (1.0 + s1) + sh1
        hc = ctx * (1.0 + cs1) + csh1
        y_c, y_l = _token_mixer(hc, hl, row, col, tpos, w_in[i], ret_decay_f[i], ret_decay_b[i], w_ret_o[i],
                                mla_q_norm[i], w_uq[i], mla_kv_norm[i], w_ukv[i], w_mla_o[i], w_out[i],
                                not last)
        x = _layer_norm(alpha * x + g1 * y_l, ln1_g[i], ln1_b[i])
        x = _layer_norm(alpha * x + g2 * _swiglu(x * (1.0 + s2) + sh2, w_gu[i], w_down[i]), ln2_g[i], ln2_b[i])
        if not last:
            ctx = _layer_norm(alpha * ctx + cg1 * y_c, ln1_g[i], ln1_b[i])
            ctx = _layer_norm(alpha * ctx + cg2 * _swiglu(ctx * (1.0 + cs2) + csh2, w_gu[i], w_down[i]),
                              ln2_g[i], ln2_b[i])
    return x
```

```cpp
#include <hip/hip_runtime.h>
#include <hip/hip_cooperative_groups.h>
#include <cstdio>
#include <cstdint>
namespace cg = cooperative_groups;
namespace pg8 {
#define PG8_LAS __attribute__((address_space(3)))
typedef unsigned short bf16_t;
typedef short bf16x8 __attribute__((ext_vector_type(8)));
typedef float f32x4 __attribute__((ext_vector_type(4)));
typedef unsigned u32x4 __attribute__((ext_vector_type(4)));
constexpr int BM = 256, BK = 64, HALF = 128, HTB = HALF * BK * 2  , STAGE_BYTES = 8 * HTB, NXCD = 8, WGM = 8;

__host__ __device__ __forceinline__ int lds_byte(int r, int c) { const int st = (r >> 4) * 2 + (c >> 5), rr = r & 15, cc = c & 31, ob = rr * 64 + cc * 2; return st * 1024 + (ob ^ (((ob >> 9) & 1) << 5)); }
__host__ __device__ __forceinline__ void stage_rc(int b, int& R, int& C) { const int st = b / 1024, sb = b % 1024, swz = sb ^ (((sb >> 9) & 1) << 5); R = (st >> 1) * 16 + swz / 64; C = (st & 1) * 32 + (swz % 64) / 2; }
__host__ __device__ __forceinline__ int perm32(int rho) { const int n = rho >> 4, i = rho & 15; return 8 * (i >> 2) + 4 * n + (i & 3); }

struct Unit { int pm, pn; };
struct Gemm { const bf16_t* A; const bf16_t* Bt; int M, N, K; };

struct StaticOrder {
    int nM, nN, nwg, G, c;
    __host__ __device__ void init(int M, int N, int G_, int c_) { nM = M / BM; nN = N / BM; nwg = nM * nN; G = G_; c = c_; }
    __host__ __device__ bool next(int i, Unit& u) const {
        const long L = (long)i * G + c; if (L >= nwg) return false;
        int wgid = (int)L; { const int q = nwg / NXCD, r = nwg % NXCD, xcd = wgid % NXCD, off = wgid / NXCD; wgid = (xcd < r ? xcd * (q + 1) : r * (q + 1) + (xcd - r) * q) + off; }
        const int nig = WGM * nN, gid = wgid / nig, fm = gid * WGM, gsz = (nM - fm) < WGM ? (nM - fm) : WGM;
        u.pm = fm + ((wgid % nig) % gsz); u.pn = (wgid % nig) / gsz; return true;
    }
    __device__ __forceinline__ void a_ready(const Unit&) const {}
    __device__ __forceinline__ void done(const Unit&) const {}
};

__device__ __forceinline__ unsigned cvt_pk_bf16(float lo, float hi) { unsigned r; asm volatile("v_cvt_pk_bf16_f32 %0, %1, %2" : "=v"(r) : "v"(lo), "v"(hi)); return r; }
typedef float f32x2 __attribute__((ext_vector_type(2)));
template <class Epi, class Sched, bool ALIGN_EPI = false, bool SP2 = false>
__device__ __forceinline__ void gemm_phase(PG8_LAS unsigned char* lds, const Gemm g, const Sched& S, const Epi& E) {
    int tid_l = threadIdx.x; asm volatile("" : "+v"(tid_l));
    const int tid = tid_l, wid = __builtin_amdgcn_readfirstlane(tid >> 6), lane = tid & 63, wr = wid >> 2, wc = wid & 3, fr = lane & 15, fq = lane >> 4;
    const int K = g.K, nt = K / BK;
    unsigned voffA[2], voffB[2];
#pragma unroll
    for (int i = 0; i < 2; ++i) { int R, C; stage_rc(tid * 16 + i * 8192, R, C); const int Rb = Epi::PERM ? ((R & ~31) + perm32(R & 31)) : R;
        voffA[i] = (unsigned)(R * K + C) * 2u; voffB[i] = (unsigned)(Rb * K + C) * 2u; }
    const size_t kstep = (size_t)(BK * 2);
    const size_t hstep = (size_t)HALF * K * 2;
    const size_t tstep = 2 * hstep;
    const unsigned ldsw = (unsigned)wid * 1024u;
    const int aoff = lds_byte(wr * 64 + fr, fq * 8), boff = lds_byte(wc * 32 + fr, fq * 8);
#define PG8_SA(b, h) (((b) * 2 + (h)) * HTB)
#define PG8_SB(b, h) ((4 + (b) * 2 + (h)) * HTB)
#define PG8_STAGE(bufoff, gbase, voff) do { _Pragma("unroll") for (int _i = 0; _i < 2; ++_i) \
        __builtin_amdgcn_global_load_lds((const unsigned*)((const char*)(gbase) + (voff)[_i]), (PG8_LAS unsigned*)(lds + (bufoff) + ldsw + _i * 8192), 16, 0, 0); } while (0)
#define PG8_LDA(dst, b, h) do { _Pragma("unroll") for (int m = 0; m < 4; ++m) _Pragma("unroll") for (int k = 0; k < 2; ++k) dst[m][k] = *(const PG8_LAS bf16x8*)(lds + PG8_SA(b, h) + aoff + m * 2048 + k * 1024); } while (0)
#define PG8_LDB(dst, b, h) do { _Pragma("unroll") for (int n = 0; n < 2; ++n) _Pragma("unroll") for (int k = 0; k < 2; ++k) dst[n][k] = *(const PG8_LAS bf16x8*)(lds + PG8_SB(b, h) + boff + n * 2048 + k * 1024); } while (0)
#define PG8_MMA(ai, bj, At, Bt) do { __builtin_amdgcn_s_setprio(1); _Pragma("unroll") for (int m = 0; m < 4; ++m) _Pragma("unroll") for (int n = 0; n < 2; ++n) _Pragma("unroll") for (int k = 0; k < 2; ++k) \
        acc[ai][bj][m][n] = __builtin_amdgcn_mfma_f32_16x16x32_bf16(Bt[n][k], At[m][k], acc[ai][bj][m][n], 0, 0, 0); __builtin_amdgcn_s_setprio(0); } while (0)
#define PG8_WAIT_V(n) asm volatile("s_waitcnt vmcnt(" #n ")" ::: "memory")
#define PG8_WAIT_L(n) asm volatile("s_waitcnt lgkmcnt(" #n ")" ::: "memory")
#define PG8_BAR __builtin_amdgcn_s_barrier()
#define PG8_SCHED __builtin_amdgcn_sched_barrier(0)
    Unit cur, nxt; int ui = 0;
    if (!S.next(0, cur)) return;
    f32x4 acc[2][2][4][2];
#pragma unroll
    for (int a = 0; a < 2; ++a)
#pragma unroll
        for (int b = 0; b < 2; ++b)
#pragma unroll
            for (int m = 0; m < 4; ++m)
#pragma unroll
                for (int n = 0; n < 2; ++n) acc[a][b][m][n] = (f32x4){0.f, 0.f, 0.f, 0.f};
    bf16x8 At[4][2], B0[2][2], B1[2][2];
    const char* cA = (const char*)g.A + (size_t)cur.pm * tstep; const char* cB = (const char*)g.Bt + (size_t)cur.pn * tstep;
    S.a_ready(cur);
    if constexpr (SP2) {
        PG8_STAGE(PG8_SB(0, 0), cB, voffB); PG8_STAGE(PG8_SB(0, 1), cB + hstep, voffB); PG8_STAGE(PG8_SA(0, 0), cA, voffA); PG8_STAGE(PG8_SA(0, 1), cA + hstep, voffA);
        if (wr == 1) PG8_BAR;
        PG8_WAIT_V(2); PG8_BAR;
        PG8_STAGE(PG8_SB(1, 0), cB + kstep, voffB); PG8_STAGE(PG8_SA(1, 0), cA + kstep, voffA); PG8_STAGE(PG8_SB(1, 1), cB + hstep + kstep, voffB);
        PG8_WAIT_V(6); PG8_BAR;
    } else {
        PG8_STAGE(PG8_SB(0, 0), cB, voffB); PG8_STAGE(PG8_SA(0, 0), cA, voffA); PG8_STAGE(PG8_SB(0, 1), cB + hstep, voffB); PG8_STAGE(PG8_SA(0, 1), cA + hstep, voffA);
        if (wr == 1) PG8_BAR;
        PG8_WAIT_V(4); PG8_BAR;
        PG8_STAGE(PG8_SB(1, 0), cB + kstep, voffB); PG8_STAGE(PG8_SA(1, 0), cA + kstep, voffA); PG8_STAGE(PG8_SB(1, 1), cB + hstep + kstep, voffB);
        PG8_WAIT_V(6); PG8_BAR;
    }
    for (;;) {
        const bool has_next = S.next(ui + 1, nxt);
        const char* nA = has_next ? (const char*)g.A + (size_t)nxt.pm * tstep : cA; const char* nB = has_next ? (const char*)g.Bt + (size_t)nxt.pn * tstep : cB;
        for (int t = 0; t < nt; t += 2) {
            const bool last = (t == nt - 2);
            const char* a1 = cA + (size_t)(t + 1) * kstep;
            const char* a2 = last ? nA : cA + (size_t)(t + 2) * kstep; const char* b2 = last ? nB : cB + (size_t)(t + 2) * kstep;
            const char* a3 = a2 + kstep; const char* b3 = b2 + kstep;
            if (last && has_next) S.a_ready(nxt);
            if constexpr (SP2) {
            PG8_LDB(B0, 0, 0); PG8_LDB(B1, 0, 1); PG8_SCHED; PG8_LDA(At, 0, 0); PG8_STAGE(PG8_SA(1, 1), a1 + hstep, voffA);
            PG8_WAIT_V(8); PG8_WAIT_L(0); PG8_BAR; PG8_MMA(0, 0, At, B0); PG8_MMA(0, 1, At, B1); PG8_BAR; PG8_SCHED;
            PG8_LDA(At, 0, 1); PG8_STAGE(PG8_SB(0, 0), b2, voffB); PG8_STAGE(PG8_SB(0, 1), b2 + hstep, voffB); PG8_STAGE(PG8_SA(0, 0), a2, voffA);
            PG8_WAIT_V(8); PG8_WAIT_L(0); PG8_BAR; PG8_MMA(1, 0, At, B0); PG8_MMA(1, 1, At, B1); PG8_BAR; PG8_SCHED;
            PG8_LDB(B0, 1, 0); PG8_LDB(B1, 1, 1); PG8_SCHED; PG8_LDA(At, 1, 0); PG8_STAGE(PG8_SA(0, 1), a2 + hstep, voffA);
            PG8_WAIT_V(8); PG8_WAIT_L(0); PG8_BAR; PG8_MMA(0, 0, At, B0); PG8_MMA(0, 1, At, B1); PG8_BAR; PG8_SCHED;
            PG8_LDA(At, 1, 1); PG8_STAGE(PG8_SB(1, 0), b3, voffB); PG8_STAGE(PG8_SB(1, 1), b3 + hstep, voffB); PG8_STAGE(PG8_SA(1, 0), a3, voffA);
            PG8_WAIT_V(8); PG8_WAIT_L(0); PG8_BAR; PG8_MMA(1, 0, At, B0); PG8_MMA(1, 1, At, B1); PG8_BAR; PG8_SCHED;
            } else {
            PG8_LDB(B0, 0, 0); PG8_SCHED; PG8_LDA(At, 0, 0); PG8_STAGE(PG8_SA(1, 1), a1 + hstep, voffA);
            PG8_WAIT_L(8); PG8_BAR; PG8_WAIT_L(0); PG8_MMA(0, 0, At, B0); PG8_BAR; PG8_SCHED;
            PG8_LDB(B1, 0, 1); PG8_STAGE(PG8_SB(0, 0), b2, voffB);
            PG8_BAR; PG8_WAIT_L(0); PG8_MMA(0, 1, At, B1); PG8_BAR;
            PG8_LDA(At, 0, 1); PG8_STAGE(PG8_SA(0, 0), a2, voffA);
            PG8_BAR; PG8_WAIT_L(0); PG8_MMA(1, 0, At, B0); PG8_BAR; PG8_SCHED;
            PG8_STAGE(PG8_SB(0, 1), b2 + hstep, voffB);
            PG8_WAIT_V(6); PG8_BAR; PG8_MMA(1, 1, At, B1); PG8_BAR;
            PG8_LDB(B0, 1, 0); PG8_SCHED; PG8_LDA(At, 1, 0); PG8_STAGE(PG8_SA(0, 1), a2 + hstep, voffA);
            PG8_WAIT_L(8); PG8_BAR; PG8_WAIT_L(0); PG8_MMA(0, 0, At, B0); PG8_BAR; PG8_SCHED;
            PG8_LDB(B1, 1, 1); PG8_STAGE(PG8_SB(1, 0), b3, voffB);
            PG8_BAR; PG8_WAIT_L(0); PG8_MMA(0, 1, At, B1); PG8_BAR;
            PG8_LDA(At, 1, 1); PG8_STAGE(PG8_SA(1, 0), a3, voffA);
            PG8_BAR; PG8_WAIT_L(0); PG8_MMA(1, 0, At, B0); PG8_BAR; PG8_SCHED;
            PG8_STAGE(PG8_SB(1, 1), b3 + hstep, voffB);
            PG8_WAIT_V(6); PG8_BAR; PG8_MMA(1, 1, At, B1); PG8_BAR;
            }
        }
        if constexpr (ALIGN_EPI) { if (wr == 0) PG8_BAR; }
        if constexpr (!Epi::AFTER_DRAIN) { E(acc, cur, wr, wc, fr, fq); S.done(cur); }
        if (!has_next) break;
#pragma unroll
        for (int a = 0; a < 2; ++a)
#pragma unroll
            for (int b = 0; b < 2; ++b)
#pragma unroll
                for (int m = 0; m < 4; ++m)
#pragma unroll
                    for (int n = 0; n < 2; ++n) acc[a][b][m][n] = (f32x4){0.f, 0.f, 0.f, 0.f};
        cur = nxt; cA = nA; cB = nB; ++ui;
        if constexpr (ALIGN_EPI) { if (wr == 1) PG8_BAR; }
    }
    PG8_WAIT_V(0);
    if constexpr (!ALIGN_EPI) { if (wr == 0) PG8_BAR; }
    PG8_BAR;
    if constexpr (Epi::AFTER_DRAIN) { E.fused(acc, cur, wr, wc, fr, fq, lds, wid, lane); S.done(cur); }
#undef PG8_SA
#undef PG8_SB
#undef PG8_STAGE
#undef PG8_LDA
#undef PG8_LDB
#undef PG8_MMA
#undef PG8_WAIT_V
#undef PG8_WAIT_L
#undef PG8_BAR
#undef PG8_SCHED
}
}

#define LAS __attribute__((address_space(3)))
#define DI __device__ __forceinline__
typedef unsigned short bf16;
typedef short bf16x8 __attribute__((ext_vector_type(8)));
typedef short s16x4 __attribute__((ext_vector_type(4)));
typedef short v4i16_t __attribute__((ext_vector_type(4)));
typedef float f32x4 __attribute__((ext_vector_type(4)));
typedef float f32x16 __attribute__((ext_vector_type(16)));
typedef unsigned u32x4 __attribute__((ext_vector_type(4)));
typedef unsigned u32x2 __attribute__((ext_vector_type(2)));
typedef float f32x2_t __attribute__((ext_vector_type(2)));
typedef __bf16 bf16x2_t __attribute__((ext_vector_type(2)));
#define MFMA32(a, b, c) __builtin_amdgcn_mfma_f32_32x32x16_bf16((a), (b), (c), 0, 0, 0)

constexpr int DM = 1024, NBAT = 4, SEQ = 4096, CTX = 256, ML = NBAT * SEQ, MC = NBAT * CTX, MT = ML + MC, KEYS = CTX + SEQ;
constexpr int NIN = 5888, INW = 5792, DFF = 2816, NGU = 5632;
constexpr size_t MiB = 1u << 20;
constexpr size_t O_WGU = 0, O_WDN = O_WGU + (size_t)NGU * 1024 * 2, O_WOUT = O_WDN + (size_t)1024 * DFF * 2, O_WRO = O_WOUT + 2 * MiB, O_WMO = O_WRO + 2 * MiB,
                 O_WUQ = O_WMO + 1 * MiB, O_WUKV = O_WUQ + 768 * 384 * 2, O_MOD = O_WUKV + 1024 * 256 * 2, O_T1 = O_MOD + 5 * 6144 * 4, O_T2 = O_T1 + 4096 * 64 * 8,
                 O_SS = O_T2 + 64 * 8 * 8, O_MISC_END = O_SS + (size_t)MT * 24 * 4;
static_assert(O_MISC_END <= 27 * MiB, "misc region");
constexpr size_t O_RQ = 27 * MiB, O_RK = 43 * MiB, O_RV = 60 * MiB, O_RG = 94 * MiB, O_GR = 126 * MiB, O_GM = 158 * MiB, O_DQ = 190 * MiB, O_DKV = 202 * MiB,
                 O_WIN = 211 * MiB, O_KR = 254 * MiB, O_KN = 211 * MiB, O_VN = 228 * MiB, O_AO = 190 * MiB, O_GMX = 27 * MiB, O_X1 = 94 * MiB, O_H2 = 59 * MiB, O_H = 158 * MiB,
                 WS_NEED = 256 * MiB;
constexpr size_t OO_QM = 32 * MiB;
constexpr int LDS_BYTES = 147456;
constexpr float ALPHA = 1.189207115002721f;
constexpr float LN_EPS = 1e-5f, RMS_EPS = 1e-6f;
constexpr float QSCALE = 0.10206207261596575f * 1.4426950408889634f;
constexpr float KSCALE = 0.08838834764831845f;

struct Params {
    const float *x, *c, *ctx, *c_ctx, *w_ada, *b_ada, *w_in, *dec_f, *dec_b, *w_ret_o, *q_norm, *w_uq, *kv_norm, *w_ukv, *w_mla_o, *w_out, *ln1_g, *ln1_b, *w_gu, *w_down, *ln2_g, *ln2_b;
    float* out; unsigned char* ws;
};

DI unsigned cvtpk(float lo, float hi) { f32x2_t v = {lo, hi}; bf16x2_t b = __builtin_convertvector(v, bf16x2_t); return __builtin_bit_cast(unsigned, b); }
DI float bflo(unsigned u) { return __uint_as_float(u << 16); }
DI float bfhi(unsigned u) { return __uint_as_float(u & 0xffff0000u); }
DI float bf2f(bf16 v) { return __uint_as_float(((unsigned)v) << 16); }
DI bf16 f2bf(float f) { return (bf16)(cvtpk(f, 0.f) & 0xffffu); }
DI u32x4 pack8(const float (&v)[8]) { u32x4 w; w.x = cvtpk(v[0], v[1]); w.y = cvtpk(v[2], v[3]); w.z = cvtpk(v[4], v[5]); w.w = cvtpk(v[6], v[7]); return w; }
DI void unpack8(u32x4 w, float (&v)[8]) { v[0] = bflo(w.x); v[1] = bfhi(w.x); v[2] = bflo(w.y); v[3] = bfhi(w.y); v[4] = bflo(w.z); v[5] = bfhi(w.z); v[6] = bflo(w.w); v[7] = bfhi(w.w); }
DI float fexp2(float x) { return __builtin_amdgcn_exp2f(x); }
DI float silu_f(float v) { return v / (1.f + __expf(-v)); }
DI float sigm_f(float v) { return 1.f / (1.f + __expf(-v)); }
DI s16x4 trr(unsigned addr) { return __builtin_bit_cast(s16x4, __builtin_amdgcn_ds_read_tr16_b64_v4i16((LAS v4i16_t*)addr)); }
DI bf16x8 cat4(s16x4 lo, s16x4 hi) { return __builtin_shufflevector(lo, hi, 0, 1, 2, 3, 4, 5, 6, 7); }
DI int crow(int reg, int h) { return (reg & 3) + 8 * (reg >> 2) + 4 * h; }
DI bf16x8 packstep(const f32x16& x, int s) { u32x4 p; p.x = cvtpk(x[8 * s], x[8 * s + 1]); p.y = cvtpk(x[8 * s + 2], x[8 * s + 3]); p.z = cvtpk(x[8 * s + 4], x[8 * s + 5]); p.w = cvtpk(x[8 * s + 6], x[8 * s + 7]); return __builtin_bit_cast(bf16x8, p); }
DI float wave_sum(float v) {
#pragma unroll
    for (int o = 1; o < 64; o <<= 1) v += __shfl_xor(v, o);
    return v;
}

template <class F> struct EpiG {
    static constexpr bool PERM = true, AFTER_DRAIN = false;
    F f;
    __device__ __forceinline__ void operator()(const pg8::f32x4 (&acc)[2][2][4][2], const pg8::Unit& u, int wr_, int wc_, int fr_, int fq_) const {
        int t_ = threadIdx.x; asm volatile("" : "+v"(t_));
        const int wid_ = __builtin_amdgcn_readfirstlane(t_ >> 6), wr = wid_ >> 2, wc = wid_ & 3, fr = t_ & 15, fq = (t_ >> 4) & 3;
#pragma unroll
        for (int ai = 0; ai < 2; ++ai)
#pragma unroll
            for (int m = 0; m < 4; ++m) {
                const int row = u.pm * 256 + ai * 128 + wr * 64 + m * 16 + fr;
#pragma unroll
                for (int bj = 0; bj < 2; ++bj) {
                    const int col0 = u.pn * 256 + bj * 128 + wc * 32 + 8 * fq;
                    float v[8];
#pragma unroll
                    for (int j = 0; j < 4; ++j) { v[j] = acc[ai][bj][m][0][j]; v[4 + j] = acc[ai][bj][m][1][j]; }
                    f(row, col0, v, u.pn);
                    asm volatile("" ::: "memory");
                }
            }
    }
};

struct FIn {
    bf16 *RQ, *RK, *RV, *RG, *GR, *GM, *DQ, *DKV, *KR; float* SS; const float* T1; const float* T2;
    DI void rope4(float (&v)[8], const float* cs) const {
        const f32x4 a = *(const f32x4*)cs, b = *(const f32x4*)(cs + 4);
        const float c0 = a[0], s0 = a[1], c1 = a[2], s1 = a[3], c2 = b[0], s2 = b[1], c3 = b[2], s3 = b[3];
        float t;
        t = v[0] * c0 - v[1] * s0; v[1] = v[1] * c0 + v[0] * s0; v[0] = t;
        t = v[2] * c1 - v[3] * s1; v[3] = v[3] * c1 + v[2] * s1; v[2] = t;
        t = v[4] * c2 - v[5] * s2; v[5] = v[5] * c2 + v[4] * s2; v[4] = t;
        t = v[6] * c3 - v[7] * s3; v[7] = v[7] * c3 + v[6] * s3; v[6] = t;
    }
    DI void operator()(int row, int col0, float (&v)[8], int pn) const {
        const bool lat = row < ML;
        if (pn < 4) {
            if (lat) { const int pos = row & (SEQ - 1), i0 = (col0 & 127) >> 1; rope4(v, T1 + ((size_t)pos * 64 + i0) * 2); }
            if (pn < 2) { if (lat) *(u32x4*)(RQ + (size_t)row * 512 + col0) = pack8(v); }
            else {
#pragma unroll
                for (int j = 0; j < 8; ++j) v[j] *= KSCALE;
                *(u32x4*)(RK + (size_t)row * 512 + (col0 - 512)) = pack8(v);
            }
        } else if (pn < 8) {
            *(u32x4*)(RV + (size_t)row * 1024 + (col0 - 1024)) = pack8(v);
        } else if (pn < 12) {
            if (lat) {
#pragma unroll
                for (int j = 0; j < 8; ++j) v[j] = silu_f(v[j]);
                *(u32x4*)(RG + (size_t)row * 1024 + (col0 - 2048)) = pack8(v); }
        } else if (pn < 20) {
            if (lat) {
#pragma unroll
                for (int j = 0; j < 8; ++j) v[j] = sigm_f(v[j]);
                bf16* dst = pn < 16 ? GR + (size_t)row * 1024 + (col0 - 3072) : GM + (size_t)row * 1024 + (col0 - 4096);
                *(u32x4*)dst = pack8(v); }
        } else {
            float s = 0.f;
#pragma unroll
            for (int j = 0; j < 8; ++j) s += v[j] * v[j];
            s += __shfl_xor(s, 16); s += __shfl_xor(s, 32);
            const int c = col0 - 5120;
            if ((threadIdx.x & 63) < 16) SS[(size_t)row * 24 + (c >> 5)] = s;
            if (c < 384) { if (lat) *(u32x4*)(DQ + (size_t)row * 384 + c) = pack8(v); }
            else if (c < 640) { *(u32x4*)(DKV + (size_t)row * 256 + (c - 384)) = pack8(v); }
            else if (c < 672) {
                const int r = c - 640;
                int b, key;
                if (lat) { b = row >> 12; key = CTX + (row & (SEQ - 1)); const int t = row & (SEQ - 1); const int p = (r < 16) ? (t >> 6) : (t & 63); const int i0 = (r & 15) >> 1; rope4(v, T2 + (p * 8 + i0) * 2); }
                else { b = (row - ML) >> 8; key = (row - ML) & 255; }
                *(u32x4*)(KR + ((size_t)b * KEYS + key) * 32 + r) = pack8(v);
            }
        }
    }
};
struct FQ {
    bf16* QM; const float* SS; const float* T2;
    DI void operator()(int row, int col0, float (&v)[8], int) const {
        const f32x4 a = *(const f32x4*)(SS + (size_t)row * 24), b = *(const f32x4*)(SS + (size_t)row * 24 + 4), c = *(const f32x4*)(SS + (size_t)row * 24 + 8);
        const float ss = ((a[0] + a[1]) + (a[2] + a[3])) + ((b[0] + b[1]) + (b[2] + b[3])) + ((c[0] + c[1]) + (c[2] + c[3]));
        const float sc = rsqrtf(ss * (1.f / 384.f) + RMS_EPS) * QSCALE;
#pragma unroll
        for (int j = 0; j < 8; ++j) v[j] *= sc;
        const int h = col0 / 96, d0 = col0 - 96 * h, bb = row >> 12, t = row & (SEQ - 1);
        if (d0 >= 64) {
            const int r = d0 - 64; const int p = (r < 16) ? (t >> 6) : (t & 63); const int i0 = (r & 15) >> 1;
            const float* cs = T2 + (p * 8 + i0) * 2;
            const f32x4 ca = *(const f32x4*)cs, cb = *(const f32x4*)(cs + 4);
            float tt;
            tt = v[0] * ca[0] - v[1] * ca[1]; v[1] = v[1] * ca[0] + v[0] * ca[1]; v[0] = tt;
            tt = v[2] * ca[2] - v[3] * ca[3]; v[3] = v[3] * ca[2] + v[2] * ca[3]; v[2] = tt;
            tt = v[4] * cb[0] - v[5] * cb[1]; v[5] = v[5] * cb[0] + v[4] * cb[1]; v[4] = tt;
            tt = v[6] * cb[2] - v[7] * cb[3]; v[7] = v[7] * cb[2] + v[6] * cb[3]; v[6] = tt;
        }
        *(u32x4*)(QM + ((size_t)(bb * 8 + h) * SEQ + t) * 96 + d0) = pack8(v);
    }
};
struct FKV {
    bf16 *KN, *VN; const float* SS;
    DI void operator()(int row, int col0, float (&v)[8], int) const {
        const f32x4 a = *(const f32x4*)(SS + (size_t)row * 24 + 12), b = *(const f32x4*)(SS + (size_t)row * 24 + 16);
        const float ss = ((a[0] + a[1]) + (a[2] + a[3])) + ((b[0] + b[1]) + (b[2] + b[3]));
        const float sc = rsqrtf(ss * (1.f / 256.f) + RMS_EPS);
#pragma unroll
        for (int j = 0; j < 8; ++j) v[j] *= sc;
        int bb, key;
        if (row < ML) { bb = row >> 12; key = CTX + (row & (SEQ - 1)); } else { bb = (row - ML) >> 8; key = (row - ML) & 255; }
        const int h = col0 >> 7, r = col0 & 127;
        bf16* dst = (r < 64) ? KN + ((size_t)(bb * 8 + h) * KEYS + key) * 64 + r : VN + ((size_t)(bb * 8 + h) * KEYS + key) * 64 + (r - 64);
        *(u32x4*)dst = pack8(v);
    }
};
struct F5a { float* T; const bf16* GR;
    DI void operator()(int row, int col0, float (&v)[8], int) const {
        float g[8]; unpack8(*(const u32x4*)(GR + (size_t)row * 1024 + col0), g);
        f32x4 o0, o1;
#pragma unroll
        for (int j = 0; j < 4; ++j) { o0[j] = g[j] * v[j]; o1[j] = g[4 + j] * v[4 + j]; }
        *(f32x4*)(T + (size_t)row * 1024 + col0) = o0; *(f32x4*)(T + (size_t)row * 1024 + col0 + 4) = o1;
    } };
struct F5b { const float* T; const bf16* GM; bf16* O;
    DI void operator()(int row, int col0, float (&v)[8], int) const {
        float g[8]; unpack8(*(const u32x4*)(GM + (size_t)row * 1024 + col0), g);
        const f32x4 t0 = *(const f32x4*)(T + (size_t)row * 1024 + col0), t1 = *(const f32x4*)(T + (size_t)row * 1024 + col0 + 4);
        float o[8];
#pragma unroll
        for (int j = 0; j < 4; ++j) { o[j] = t0[j] + g[j] * v[j]; o[4 + j] = t1[j] + g[4 + j] * v[4 + j]; }
        *(u32x4*)(O + (size_t)row * 1024 + col0) = pack8(o);
    } };
struct FRes { const float* base; const float* gate  ; float* O;
    DI void operator()(int row, int col0, float (&v)[8], int) const {
        const int bb = row >> 12;
        const f32x4 x0 = *(const f32x4*)(base + (size_t)row * 1024 + col0), x1 = *(const f32x4*)(base + (size_t)row * 1024 + col0 + 4);
        const f32x4 g0 = *(const f32x4*)(gate + bb * 6144 + col0), g1 = *(const f32x4*)(gate + bb * 6144 + col0 + 4);
        f32x4 o0, o1;
#pragma unroll
        for (int j = 0; j < 4; ++j) { o0[j] = ALPHA * x0[j] + g0[j] * v[j]; o1[j] = ALPHA * x1[j] + g1[j] * v[4 + j]; }
        *(f32x4*)(O + (size_t)row * 1024 + col0) = o0; *(f32x4*)(O + (size_t)row * 1024 + col0 + 4) = o1;
    } };
struct FGU { bf16* H;
    DI void operator()(int row, int col0, float (&v)[8], int) const {
        u32x2 w; w.x = cvtpk(silu_f(v[0]) * v[1], silu_f(v[2]) * v[3]); w.y = cvtpk(silu_f(v[4]) * v[5], silu_f(v[6]) * v[7]);
        *(u32x2*)(H + (size_t)row * DFF + (col0 >> 1)) = w;
    } };

DI int mapcol(int kind, int p) {
    switch (kind) {
    case 0: {
        if (p < 1024) { const int base = (p < 512) ? 0 : 512; const int q = p - base; const int h = q >> 7, r = q & 127; return base + h * 128 + (r >> 1) + 64 * (r & 1); }
        if (p < 2048) return p;
        if (p < 3072) return p;
        if (p < 4096) return 3744 + (p - 3072);
        if (p < 5120) return 4768 + (p - 4096);
        if (p < 5504) return 3072 + (p - 5120);
        if (p < 5760) return 3456 + (p - 5504);
        if (p < 5792) { const int r = p - 5760; const int g = r >> 4, rr = r & 15; return 3712 + 16 * g + (rr >> 1) + 8 * (rr & 1); }
        return -1; }
    case 1: return (p & 1) * DFF + (p >> 1);
    case 2: {
        const int h = p / 96, d = p - 96 * h; if (d < 64) return p; const int r = d - 64; const int g = r >> 4, rr = r & 15; return h * 96 + 64 + 16 * g + (rr >> 1) + 8 * (rr & 1); }
    default: return p;
    }
}
DI void tr_item(const float* W, int Nsrc, int K, bf16* WT, const float* rowscale, LAS float* scr, int item, int nblk, int lane, int kind) {
    const int kb = item / nblk, nb = item - kb * nblk, k0 = 64 * kb, n0 = 32 * nb;
    const int src = mapcol(kind, n0 + (lane & 31));
#pragma unroll 8
    for (int i = 0; i < 32; ++i) { const int kk = 2 * i + (lane >> 5); float v = (src >= 0) ? W[(size_t)(k0 + kk) * Nsrc + src] : 0.f; if (rowscale) v *= rowscale[k0 + kk]; scr[kk * 33 + (lane & 31)] = v; }
    asm volatile("s_waitcnt lgkmcnt(0)" ::: "memory");
    const int c = lane & 7;
#pragma unroll
    for (int j = 0; j < 4; ++j) { const int n = (lane >> 3) + 8 * j; const LAS float* s = scr + (8 * c) * 33 + n;
        u32x4 o; o.x = cvtpk(s[0 * 33], s[1 * 33]); o.y = cvtpk(s[2 * 33], s[3 * 33]); o.z = cvtpk(s[4 * 33], s[5 * 33]); o.w = cvtpk(s[6 * 33], s[7 * 33]);
        *(u32x4*)(WT + (size_t)(n0 + n) * K + k0 + 8 * c) = o; }
    asm volatile("s_waitcnt lgkmcnt(0)" ::: "memory");
}
DI void phase0(const Params& p, LAS unsigned char* lds) {
    int tid_ = threadIdx.x; asm volatile("" : "+v"(tid_));
    const int tid = tid_, lane = tid & 63, wave = tid >> 6, G = gridDim.x;
    unsigned char* ws = p.ws;
    {
        LAS float* sm = (LAS float*)lds; LAS float* part = sm + 5120;
        for (int cgp = blockIdx.x; cgp < 192; cgp += G) {
            for (int i = tid; i < 5120; i += 512) { const float v = (i < 4096) ? p.c[i] : p.c_ctx[i - 4096]; sm[i] = v / (1.f + expf(-v)); }
            __syncthreads();
            const int cq = tid & 7, ks = tid >> 3, col = cgp * 32 + cq * 4;
            float acc[5][4];
#pragma unroll
            for (int r = 0; r < 5; ++r)
#pragma unroll
                for (int j = 0; j < 4; ++j) acc[r][j] = 0.f;
#pragma unroll 4
            for (int kk = 0; kk < 16; ++kk) { const int k = ks * 16 + kk; const f32x4 w = *(const f32x4*)(p.w_ada + (size_t)k * 6144 + col);
#pragma unroll
                for (int r = 0; r < 5; ++r) { const float s = sm[r * 1024 + k];
#pragma unroll
                    for (int j = 0; j < 4; ++j) acc[r][j] += s * w[j]; } }
#pragma unroll
            for (int r = 0; r < 5; ++r)
#pragma unroll
                for (int j = 0; j < 4; ++j) part[(ks * 5 + r) * 32 + cq * 4 + j] = acc[r][j];
            __syncthreads();
            if (tid < 160) { const int r = tid >> 5, cc = tid & 31; float s = 0.f; for (int k2 = 0; k2 < 64; ++k2) s += part[(k2 * 5 + r) * 32 + cc];
                ((float*)(ws + O_MOD))[r * 6144 + cgp * 32 + cc] = s + p.b_ada[cgp * 32 + cc]; }
            __syncthreads();
        }
    }
    {
        LAS float* scr = (LAS float*)(lds + wave * 8704);
        const int gw = blockIdx.x * 8 + wave, NGW = G * 8;
        constexpr int I0 = 16 * 184, I1 = 16 * 176, I2 = 44 * 32, I3 = 16 * 32, I4 = 16 * 32, I5 = 8 * 32, I6 = 6 * 24, I7 = 4 * 32;
        constexpr int NIT = I0 + I1 + I2 + I3 + I4 + I5 + I6 + I7;
        for (int it = gw; it < NIT; it += NGW) {
            int r = it;
            if (r < I0) { tr_item(p.w_in, INW, 1024, (bf16*)(ws + O_WIN), nullptr, scr, r, 184, lane, 0); continue; } r -= I0;
            if (r < I1) { tr_item(p.w_gu, NGU, 1024, (bf16*)(ws + O_WGU), nullptr, scr, r, 176, lane, 1); continue; } r -= I1;
            if (r < I2) { tr_item(p.w_down, 1024, DFF, (bf16*)(ws + O_WDN), nullptr, scr, r, 32, lane, 9); continue; } r -= I2;
            if (r < I3) { tr_item(p.w_ret_o, 1024, 1024, (bf16*)(ws + O_WRO), nullptr, scr, r, 32, lane, 9); continue; } r -= I3;
            if (r < I4) { tr_item(p.w_out, 1024, 1024, (bf16*)(ws + O_WOUT), nullptr, scr, r, 32, lane, 9); continue; } r -= I4;
            if (r < I5) { tr_item(p.w_mla_o, 1024, 512, (bf16*)(ws + O_WMO), nullptr, scr, r, 32, lane, 9); continue; } r -= I5;
            if (r < I6) { tr_item(p.w_uq, 768, 384, (bf16*)(ws + O_WUQ), p.q_norm, scr, r, 24, lane, 2); continue; } r -= I6;
            tr_item(p.w_ukv, 1024, 256, (bf16*)(ws + O_WUKV), p.kv_norm, scr, r, 32, lane, 9);
        }
    }
    {
        float* T1 = (float*)(ws + O_T1); float* T2 = (float*)(ws + O_T2);
        const int gt = blockIdx.x * 512 + tid, NT = G * 512;
        for (int e = gt; e < 4096 * 64 + 64 * 8; e += NT) {
            float pos, fr; float* dst;
            if (e < 4096 * 64) { pos = (float)(e >> 6); fr = exp2f(-(float)(e & 63) * (13.287712379549449f / 64.f)); dst = T1 + 2 * e; }
            else { const int e2 = e - 4096 * 64; pos = (float)(e2 >> 3); fr = exp2f(-(float)(e2 & 7) * (13.287712379549449f / 8.f)); dst = T2 + 2 * e2; }
            const float ang = pos * fr;
            const double a = (double)ang; const double n = rint(a * 0.15915494309189535); const float rr = (float)(a - n * 6.283185307179586);
            dst[0] = cosf(rr); dst[1] = sinf(rr);
        }
    }
}
DI void phase1(const Params& p) {
    int tid_ = threadIdx.x; asm volatile("" : "+v"(tid_));
    const int lane = tid_ & 63, gw = blockIdx.x * 8 + (tid_ >> 6), NGW = gridDim.x * 8;
    const float* mod = (const float*)(p.ws + O_MOD);
    bf16* A1 = (bf16*)p.out;
    for (int m = gw; m < MT; m += NGW) {
        const float* xr; const float* md;
        if (m < ML) { xr = p.x + (size_t)m * 1024; md = mod + (m >> 12) * 6144; } else { xr = p.ctx + (size_t)(m - ML) * 1024; md = mod + 4 * 6144; }
#pragma unroll
        for (int j = 0; j < 4; ++j) { const int k = 4 * lane + 256 * j; const f32x4 v = *(const f32x4*)(xr + k), sh = *(const f32x4*)(md + k), sc = *(const f32x4*)(md + 1024 + k);
            u32x2 w; w.x = cvtpk(v[0] * (1.f + sc[0]) + sh[0], v[1] * (1.f + sc[1]) + sh[1]); w.y = cvtpk(v[2] * (1.f + sc[2]) + sh[2], v[3] * (1.f + sc[3]) + sh[3]);
            *(u32x2*)(A1 + (size_t)m * 1024 + k) = w; }
    }
}
DI void ln_pass(const float* V, float* Y, const float* g, const float* bta, bf16* H2, const float* mod) {
    int tid_ = threadIdx.x; asm volatile("" : "+v"(tid_));
    const int lane = tid_ & 63, gw = blockIdx.x * 8 + (tid_ >> 6), NGW = gridDim.x * 8;
    for (int m = gw; m < ML; m += NGW) {
        f32x4 v[4]; float s = 0.f;
#pragma unroll
        for (int j = 0; j < 4; ++j) { v[j] = *(const f32x4*)(V + (size_t)m * 1024 + 4 * lane + 256 * j); s += (v[j][0] + v[j][1]) + (v[j][2] + v[j][3]); }
        const float mean = wave_sum(s) * (1.f / 1024.f); float s2 = 0.f;
#pragma unroll
        for (int j = 0; j < 4; ++j) { v[j] = v[j] - mean; s2 += (v[j][0] * v[j][0] + v[j][1] * v[j][1]) + (v[j][2] * v[j][2] + v[j][3] * v[j][3]); }
        const float rstd = rsqrtf(wave_sum(s2) * (1.f / 1024.f) + LN_EPS);
        const float* md = mod + (m >> 12) * 6144;
#pragma unroll
        for (int j = 0; j < 4; ++j) { const int k = 4 * lane + 256 * j; const f32x4 gg = *(const f32x4*)(g + k), bb = *(const f32x4*)(bta + k);
            f32x4 y;
#pragma unroll
            for (int e = 0; e < 4; ++e) y[e] = v[j][e] * rstd * gg[e] + bb[e];
            *(f32x4*)(Y + (size_t)m * 1024 + k) = y;
            if (H2) { const f32x4 sh = *(const f32x4*)(md + 3072 + k), sc = *(const f32x4*)(md + 4096 + k);
                u32x2 w; w.x = cvtpk(y[0] * (1.f + sc[0]) + sh[0], y[1] * (1.f + sc[1]) + sh[1]); w.y = cvtpk(y[2] * (1.f + sc[2]) + sh[2], y[3] * (1.f + sc[3]) + sh[3]);
                *(u32x2*)(H2 + (size_t)m * 1024 + k) = w; } }
    }
}

constexpr int SC_KP = 272, SC_VP = 144, SC_K = 0, SC_V = 2 * 128 * SC_KP, SC_ST = SC_V + 2 * 128 * SC_VP, SC_END = SC_ST + 2 * 64 * SC_KP;
static_assert(SC_END <= LDS_BYTES, "scan lds");
DI void scan_item(const Params& p, LAS unsigned char* lds, int item) {
    int tid_ = threadIdx.x; asm volatile("" : "+v"(tid_));
    const int tid = tid_, lane = tid & 63, w = tid >> 6, rb = w >> 1, vb = w & 1, l31 = lane & 31, hh = lane >> 5;
    const int b = item >> 4, h = (item >> 2) & 3, dvs = item & 3;
    const bf16* RQ = (const bf16*)(p.ws + O_RQ); const bf16* RK = (const bf16*)(p.ws + O_RK); const bf16* RV = (const bf16*)(p.ws + O_RV);
    bf16* OC = (bf16*)p.out;
    const unsigned ldsb = (unsigned)(size_t)lds;
    float lg2[2], gC[2];
    { const float df = p.dec_f[h], db = p.dec_b[h]; lg2[0] = -log1pf(expf(-df)) * 1.4426950408889634f; lg2[1] = -log1pf(expf(-db)) * 1.4426950408889634f; gC[0] = exp2f(lg2[0] * 128.f); gC[1] = exp2f(lg2[1] * 128.f); }
    float vw[2][2];
#pragma unroll
    for (int i = 0; i < 2; ++i) { const int row = (tid >> 3) + 64 * i; vw[0][i] = exp2f(lg2[0] * (float)(127 - row)); vw[1][i] = exp2f(lg2[1] * (float)row); }
    f32x16 S[2];
#pragma unroll
    for (int d = 0; d < 2; ++d)
#pragma unroll
        for (int r = 0; r < 16; ++r) S[d][r] = 0.f;
    u32x4 kst[2][4], vst[2][2];
    auto rowbase = [&](int n, int dir) -> int {
        if (n < 2) return ML + b * CTX + (dir == 0 ? n : 1 - n) * 128;
        return b * SEQ + (dir == 0 ? n - 2 : 33 - n) * 128;
    };
#define SC_ISSUE(n_) do { _Pragma("unroll") for (int dir = 0; dir < 2; ++dir) { const int rb0 = rowbase((n_), dir); \
        _Pragma("unroll") for (int i = 0; i < 4; ++i) { const int id = tid + 512 * i; kst[dir][i] = *(const u32x4*)(RK + (size_t)(rb0 + (id >> 4)) * 512 + h * 128 + (id & 15) * 8); } \
        _Pragma("unroll") for (int i = 0; i < 2; ++i) { const int id = tid + 512 * i; vst[dir][i] = *(const u32x4*)(RV + (size_t)(rb0 + (id >> 3)) * 1024 + h * 256 + dvs * 64 + (id & 7) * 8); } } } while (0)
    SC_ISSUE(0);
    for (int n = 0; n < 34; ++n) {
        const bool lat = n >= 2;
        bf16x8 qf[8];
        if (lat) { const bf16* q = RQ + (size_t)(rowbase(n, 0) + 32 * rb + l31) * 512 + h * 128 + 8 * hh;
#pragma unroll
            for (int s = 0; s < 8; ++s) qf[s] = *(const bf16x8*)(q + 16 * s); }
#pragma unroll
        for (int dir = 0; dir < 2; ++dir) {
#pragma unroll
            for (int i = 0; i < 4; ++i) { const int id = tid + 512 * i; *(LAS u32x4*)(lds + SC_K + dir * 128 * SC_KP + (id >> 4) * SC_KP + (id & 15) * 16) = kst[dir][i]; }
#pragma unroll
            for (int i = 0; i < 2; ++i) { const int id = tid + 512 * i; float t[8]; unpack8(vst[dir][i], t);
#pragma unroll
                for (int j = 0; j < 8; ++j) t[j] *= vw[dir][i];
                *(LAS u32x4*)(lds + SC_V + dir * 128 * SC_VP + (id >> 3) * SC_VP + (id & 7) * 16) = pack8(t); }
#pragma unroll
            for (int g = 0; g < 4; ++g) { u32x2 wv; wv.x = cvtpk(S[dir][4 * g], S[dir][4 * g + 1]); wv.y = cvtpk(S[dir][4 * g + 2], S[dir][4 * g + 3]);
                *(LAS u32x2*)(lds + SC_ST + dir * 64 * SC_KP + (32 * vb + l31) * SC_KP + (32 * rb + 8 * g + 4 * hh) * 2) = wv; }
        }
        __syncthreads();
        if (n + 1 < 34) SC_ISSUE(n + 1);
#pragma unroll
        for (int dir = 0; dir < 2; ++dir) {
            if (lat) {
                f32x16 o;
#pragma unroll
                for (int r = 0; r < 16; ++r) o[r] = 0.f;
#pragma unroll
                for (int s = 0; s < 8; ++s) { const bf16x8 bfr = *(const LAS bf16x8*)(lds + SC_ST + dir * 64 * SC_KP + (32 * vb + l31) * SC_KP + (16 * s + 8 * hh) * 2); o = MFMA32(qf[s], bfr, o); }
                if (dir == 0) { const bf16* q = RQ + (size_t)(rowbase(n, 1) + 32 * rb + l31) * 512 + h * 128 + 8 * hh;
#pragma unroll
                    for (int s = 0; s < 8; ++s) qf[s] = *(const bf16x8*)(q + 16 * s); }
                const int c = (dir == 0) ? n - 2 : 33 - n;
                const bool first = (dir == 0) ? (c < 16) : (c >= 16);
                bf16* dst = OC + (size_t)(b * SEQ + c * 128 + 32 * rb + 4 * hh) * 1024 + h * 256 + dvs * 64 + 32 * vb + l31;
                const float e0 = (dir == 0) ? (float)(32 * rb + 4 * hh + 1) : (float)(128 - 32 * rb - 4 * hh);
#pragma unroll
                for (int r = 0; r < 16; ++r) { const int io = (r & 3) + 8 * (r >> 2);
                    const float sc = fexp2(lg2[dir] * (dir == 0 ? e0 + (float)io : e0 - (float)io));
                    float val = o[r] * sc;
                    if (!first) val += bf2f(dst[(size_t)io * 1024]);
                    dst[(size_t)io * 1024] = f2bf(val); }
            }
#pragma unroll
            for (int r = 0; r < 16; ++r) S[dir][r] *= gC[dir];
            const int q4 = (lane & 15) >> 2, p4 = lane & 3, blk = (lane >> 4) & 1;
            const unsigned ka = ldsb + SC_K + dir * 128 * SC_KP + (8 * hh + q4) * SC_KP + (32 * rb + 16 * blk) * 2 + 8 * p4;
            const unsigned va = ldsb + SC_V + dir * 128 * SC_VP + (8 * hh + q4) * SC_VP + (32 * vb + 16 * blk) * 2 + 8 * p4;
#pragma unroll
            for (int s = 0; s < 8; ++s) {
                const bf16x8 af = cat4(trr(ka + (16 * s) * SC_KP), trr(ka + (16 * s + 4) * SC_KP));
                const bf16x8 bfr = cat4(trr(va + (16 * s) * SC_VP), trr(va + (16 * s + 4) * SC_VP));
                S[dir] = MFMA32(af, bfr, S[dir]);
            }
        }
        __syncthreads();
    }
#undef SC_ISSUE
}

constexpr int RO_VP = 528, RO_STAT = 128 * RO_VP;
DI void retout_item(const Params& p, LAS unsigned char* lds, int item) {
    int tid_ = threadIdx.x; asm volatile("" : "+v"(tid_));
    const int tid = tid_, lane = tid & 63, w = tid >> 6, iblk = w & 3, dvh = w >> 2, l31 = lane & 31, hh = lane >> 5;
    const int b = item >> 7, h = (item >> 5) & 3, c = item & 31;
    const bf16* RQ = (const bf16*)(p.ws + O_RQ); const bf16* RK = (const bf16*)(p.ws + O_RK); const bf16* RV = (const bf16*)(p.ws + O_RV);
    const bf16* OC = (const bf16*)p.out; bf16* RG = (bf16*)(p.ws + O_RG);
    const unsigned ldsb = (unsigned)(size_t)lds;
    const int row0 = b * SEQ + c * 128;
    const float lgf = -log1pf(expf(-p.dec_f[h])) * 1.4426950408889634f, lgb = -log1pf(expf(-p.dec_b[h])) * 1.4426950408889634f;
#pragma unroll
    for (int i = 0; i < 8; ++i) { const int id = tid + 512 * i; const u32x4 v = *(const u32x4*)(RV + (size_t)(row0 + (id >> 5)) * 1024 + h * 256 + (id & 31) * 8);
        *(LAS u32x4*)(lds + (id >> 5) * RO_VP + (id & 31) * 16) = v; }
    bf16x8 qf[8];
    { const bf16* q = RQ + (size_t)(row0 + 32 * iblk + l31) * 512 + h * 128 + 8 * hh;
#pragma unroll
        for (int s = 0; s < 8; ++s) qf[s] = *(const bf16x8*)(q + 16 * s); }
    bf16x8 pf[4][2];
    const int icol = 32 * iblk + l31;
#pragma unroll
    for (int jb = 0; jb < 4; ++jb) {
        f32x16 x;
#pragma unroll
        for (int r = 0; r < 16; ++r) x[r] = 0.f;
        const bf16* kp = RK + (size_t)(row0 + 32 * jb + l31) * 512 + h * 128 + 8 * hh;
#pragma unroll
        for (int s = 0; s < 8; ++s) { const bf16x8 kf = *(const bf16x8*)(kp + 16 * s); x = MFMA32(kf, qf[s], x); }
        if (jb < iblk) {
#pragma unroll
            for (int r = 0; r < 16; ++r) { const int df = icol - (32 * jb + crow(r, hh)); x[r] *= fexp2(lgf * (float)df); }
        } else if (jb > iblk) {
#pragma unroll
            for (int r = 0; r < 16; ++r) { const int df = icol - (32 * jb + crow(r, hh)); x[r] *= fexp2(-lgb * (float)df); }
        } else {
#pragma unroll
            for (int r = 0; r < 16; ++r) { const int df = icol - (32 * jb + crow(r, hh)); const float fd = (float)df;
                const float e = fexp2(fminf(lgf * fd, -lgb * fd)); x[r] *= (df == 0) ? 2.f : e; }
        }
        pf[jb][0] = packstep(x, 0); pf[jb][1] = packstep(x, 1);
    }
    __syncthreads();
    f32x16 ot[4];
    {
        const int q4 = (lane & 15) >> 2, p4 = lane & 3, blk = (lane >> 4) & 1;
#pragma unroll
        for (int dt = 0; dt < 4; ++dt) {
#pragma unroll
            for (int r = 0; r < 16; ++r) ot[dt][r] = 0.f;
            const unsigned va = ldsb + (4 * hh + q4) * RO_VP + (128 * dvh + 32 * dt + 16 * blk) * 2 + 8 * p4;
#pragma unroll
            for (int jb = 0; jb < 4; ++jb)
#pragma unroll
                for (int s = 0; s < 2; ++s) {
                    const bf16x8 af = cat4(trr(va + (32 * jb + 16 * s) * RO_VP), trr(va + (32 * jb + 16 * s + 8) * RO_VP));
                    ot[dt] = MFMA32(af, pf[jb][s], ot[dt]);
                }
        }
    }
    const size_t grow = (size_t)(row0 + icol) * 1024 + h * 256 + 128 * dvh;
    float s1 = 0.f, s2 = 0.f;
#pragma unroll
    for (int dt = 0; dt < 4; ++dt)
#pragma unroll
        for (int g = 0; g < 4; ++g) { const u32x2 ocv = *(const u32x2*)(OC + grow + 32 * dt + 8 * g + 4 * hh);
            ot[dt][4 * g] += bflo(ocv.x); ot[dt][4 * g + 1] += bfhi(ocv.x); ot[dt][4 * g + 2] += bflo(ocv.y); ot[dt][4 * g + 3] += bfhi(ocv.y);
#pragma unroll
            for (int e = 0; e < 4; ++e) { const float t = ot[dt][4 * g + e]; s1 += t; s2 += t * t; } }
    s1 += __shfl_xor(s1, 32); s2 += __shfl_xor(s2, 32);
    LAS float* st = (LAS float*)(lds + RO_STAT);
    if (hh == 0) { st[(dvh * 128 + icol) * 2] = s1; st[(dvh * 128 + icol) * 2 + 1] = s2; }
    __syncthreads();
    const float t1 = st[icol * 2] + st[(128 + icol) * 2], t2 = st[icol * 2 + 1] + st[(128 + icol) * 2 + 1];
    const float mean = t1 * (1.f / 256.f); const float var = fmaxf(t2 * (1.f / 256.f) - mean * mean, 0.f); const float rstd = rsqrtf(var + LN_EPS);
#pragma unroll
    for (int dt = 0; dt < 4; ++dt)
#pragma unroll
        for (int g = 0; g < 4; ++g) { bf16* gp = RG + grow + 32 * dt + 8 * g + 4 * hh; const u32x2 gv = *(const u32x2*)gp;
            u32x2 o; o.x = cvtpk((ot[dt][4 * g] - mean) * rstd * bflo(gv.x), (ot[dt][4 * g + 1] - mean) * rstd * bfhi(gv.x));
            o.y = cvtpk((ot[dt][4 * g + 2] - mean) * rstd * bflo(gv.y), (ot[dt][4 * g + 3] - mean) * rstd * bfhi(gv.y));
            *(u32x2*)gp = o; }
    __syncthreads();
}

constexpr int AT_KP = 208, AT_VP = 144, AT_V = 64 * AT_KP, AT_BUF = AT_V + 64 * AT_VP;
DI void attn_unit(const Params& p, LAS unsigned char* lds, int unit) {
    int tid_ = threadIdx.x; asm volatile("" : "+v"(tid_));
    const int tid = tid_, lane = tid & 63, w = tid >> 6, l31 = lane & 31, hh = lane >> 5;
    const int bh = unit >> 4, qb = unit & 15, b = bh >> 3, h = bh & 7;
    const bf16* QM = (const bf16*)((unsigned char*)p.out + OO_QM); const bf16* KN = (const bf16*)(p.ws + O_KN); const bf16* VN = (const bf16*)(p.ws + O_VN); const bf16* KR = (const bf16*)(p.ws + O_KR);
    bf16* AO = (bf16*)(p.ws + O_AO);
    const unsigned ldsb = (unsigned)(size_t)lds;
    bf16x8 qf[6];
    { const bf16* q = QM + ((size_t)bh * SEQ + qb * 256 + 32 * w + l31) * 96 + 8 * hh;
#pragma unroll
        for (int s = 0; s < 6; ++s) qf[s] = *(const bf16x8*)(q + 16 * s); }
    const bf16* kn = KN + (size_t)bh * KEYS * 64 + (size_t)(tid >> 3) * 64 + (tid & 7) * 8;
    const bf16* vn = VN + (size_t)bh * KEYS * 64 + (size_t)(tid >> 3) * 64 + (tid & 7) * 8;
    const bf16* kr = KR + (size_t)b * KEYS * 32 + (size_t)((tid & 255) >> 2) * 32 + (tid & 3) * 8;
    u32x4 sk, sv, sr;
#define AT_ISSUE(t_) do { sk = *(const u32x4*)(kn + (size_t)(t_) * 64 * 64); sv = *(const u32x4*)(vn + (size_t)(t_) * 64 * 64); if (tid < 256) sr = *(const u32x4*)(kr + (size_t)(t_) * 64 * 32); } while (0)
#define AT_WRITE(buf_) do { LAS unsigned char* bb_ = lds + (buf_) * AT_BUF; *(LAS u32x4*)(bb_ + (tid >> 3) * AT_KP + (tid & 7) * 16) = sk; *(LAS u32x4*)(bb_ + AT_V + (tid >> 3) * AT_VP + (tid & 7) * 16) = sv; \
        if (tid < 256) *(LAS u32x4*)(bb_ + (tid >> 2) * AT_KP + 128 + (tid & 3) * 16) = sr; } while (0)
    f32x16 o[2];
#pragma unroll
    for (int d = 0; d < 2; ++d)
#pragma unroll
        for (int r = 0; r < 16; ++r) o[d][r] = 0.f;
    float m = -1e30f, lsum = 0.f;
    AT_ISSUE(0); AT_WRITE(0); AT_ISSUE(1);
    __syncthreads();
    constexpr int NT = KEYS / 64;
    const int q4 = (lane & 15) >> 2, p4 = lane & 3, blk = (lane >> 4) & 1;
    for (int t = 0; t < NT; ++t) {
        const unsigned kb0 = ldsb + (t & 1) * AT_BUF;
        f32x16 x[2];
#pragma unroll
        for (int kb = 0; kb < 2; ++kb) {
#pragma unroll
            for (int r = 0; r < 16; ++r) x[kb][r] = 0.f;
#pragma unroll
            for (int s = 0; s < 6; ++s) { const bf16x8 kf = *(const LAS bf16x8*)(lds + (t & 1) * AT_BUF + (32 * kb + l31) * AT_KP + (16 * s + 8 * hh) * 2); x[kb] = MFMA32(kf, qf[s], x[kb]); }
        }
        float mx = x[0][0];
#pragma unroll
        for (int r = 1; r < 16; ++r) mx = fmaxf(mx, x[0][r]);
#pragma unroll
        for (int r = 0; r < 16; ++r) mx = fmaxf(mx, x[1][r]);
        mx = fmaxf(mx, __shfl_xor(mx, 32));
        const float mn = fmaxf(m, mx), alpha = fexp2(m - mn);
        m = mn;
        float ps = 0.f;
#pragma unroll
        for (int kb = 0; kb < 2; ++kb)
#pragma unroll
            for (int r = 0; r < 16; ++r) { const float e = fexp2(x[kb][r] - mn); x[kb][r] = e; ps += e; }
        lsum = lsum * alpha + ps;
#pragma unroll
        for (int d = 0; d < 2; ++d)
#pragma unroll
            for (int r = 0; r < 16; ++r) o[d][r] *= alpha;
        bf16x8 pf[2][2];
#pragma unroll
        for (int kb = 0; kb < 2; ++kb) { pf[kb][0] = packstep(x[kb], 0); pf[kb][1] = packstep(x[kb], 1); }
#pragma unroll
        for (int dt = 0; dt < 2; ++dt) {
            const unsigned va = kb0 + AT_V + (4 * hh + q4) * AT_VP + (32 * dt + 16 * blk) * 2 + 8 * p4;
#pragma unroll
            for (int kb = 0; kb < 2; ++kb)
#pragma unroll
                for (int s = 0; s < 2; ++s) {
                    const bf16x8 af = cat4(trr(va + (32 * kb + 16 * s) * AT_VP), trr(va + (32 * kb + 16 * s + 8) * AT_VP));
                    o[dt] = MFMA32(af, pf[kb][s], o[dt]);
                }
        }
        if (t + 1 < NT) { AT_WRITE((t + 1) & 1); if (t + 2 < NT) AT_ISSUE(t + 2); }
        __syncthreads();
    }
    const float l = lsum + __shfl_xor(lsum, 32), inv = 1.f / l;
    bf16* dst = AO + (size_t)(b * SEQ + qb * 256 + 32 * w + l31) * 512 + h * 64;
#pragma unroll
    for (int dt = 0; dt < 2; ++dt)
#pragma unroll
        for (int g = 0; g < 4; ++g) { u32x2 wv; wv.x = cvtpk(o[dt][4 * g] * inv, o[dt][4 * g + 1] * inv); wv.y = cvtpk(o[dt][4 * g + 2] * inv, o[dt][4 * g + 3] * inv);
            *(u32x2*)(dst + 32 * dt + 8 * g + 4 * hh) = wv; }
#undef AT_ISSUE
#undef AT_WRITE
}

template <class F> DI void run_gemm(LAS unsigned char* lds, const bf16* A, const bf16* Bt, int M, int N, int K, int G, int c, const F& f) {
    pg8::Gemm g{A, Bt, M, N, K}; pg8::StaticOrder S; S.init(M, N, G, c);
    EpiG<F> E{f};
    pg8::gemm_phase<EpiG<F>, pg8::StaticOrder, true, true>(lds, g, S, E);
}

typedef const __attribute__((address_space(4))) Params* KP;
#define PH_BEGIN KP q_ = kp; asm volatile("" : "+s"(q_)); const Params p = *q_; unsigned char* ws = p.ws; unsigned char* ob = (unsigned char*)p.out; const float* mod = (const float*)(ws + O_MOD); float* SS = (float*)(ws + O_SS); (void)ob; (void)mod; (void)SS;
#ifndef PH_MASK
#define PH_MASK 0xFFFFFF
#endif
__global__ void __launch_bounds__(512, 2) fwd_kernel(Params p_unused) {
#if defined(__HIP_DEVICE_COMPILE__)
    extern __shared__ __attribute__((aligned(16))) unsigned char lds_raw[];
    LAS unsigned char* lds = (LAS unsigned char*)lds_raw;
    cg::grid_group grid = cg::this_grid();
    KP kp = (KP)__builtin_amdgcn_kernarg_segment_ptr();
    const int G = gridDim.x, bx = blockIdx.x;

    if (PH_MASK & 1) { PH_BEGIN phase0(p, lds); }
    grid.sync();
    if (PH_MASK & 2) { PH_BEGIN phase1(p); }
    grid.sync();
    if (PH_MASK & 4) {
        PH_BEGIN
        FIn f{(bf16*)(ws + O_RQ), (bf16*)(ws + O_RK), (bf16*)(ws + O_RV), (bf16*)(ws + O_RG), (bf16*)(ws + O_GR), (bf16*)(ws + O_GM), (bf16*)(ws + O_DQ), (bf16*)(ws + O_DKV), (bf16*)(ws + O_KR), SS,
              (const float*)(ws + O_T1), (const float*)(ws + O_T2)};
        run_gemm(lds, (const bf16*)ob, (const bf16*)(ws + O_WIN), MT, NIN, 1024, G, bx, f);
    }
    grid.sync();
    {
        if ((PH_MASK & 8) && G > 64 && bx >= 64) {
            { PH_BEGIN FQ fq{(bf16*)(ob + OO_QM), SS, (const float*)(ws + O_T2)};
              run_gemm(lds, (const bf16*)(ws + O_DQ), (const bf16*)(ws + O_WUQ), ML, 768, 384, G - 64, bx - 64, fq); }
            { PH_BEGIN FKV fkv{(bf16*)(ws + O_KN), (bf16*)(ws + O_VN), SS};
              run_gemm(lds, (const bf16*)(ws + O_DKV), (const bf16*)(ws + O_WUKV), MT, 1024, 256, G - 64, bx - 64, fkv); }
        } else if ((PH_MASK & 16) && bx < 64) {
            PH_BEGIN scan_item(p, lds, bx);
        }
    }
    grid.sync();
    {
        if (PH_MASK & 32) { PH_BEGIN for (int it = bx; it < 512; it += G) retout_item(p, lds, it); }
        if (PH_MASK & 64) { PH_BEGIN for (int u = bx; u < 512; u += G) attn_unit(p, lds, u); }
    }
    grid.sync();
    if (PH_MASK & 128) {
        { PH_BEGIN F5a fa{p.out, (const bf16*)(ws + O_GR)};
          run_gemm(lds, (const bf16*)(ws + O_RG), (const bf16*)(ws + O_WRO), ML, 1024, 1024, G, bx, fa); }
        { PH_BEGIN F5b fb{p.out, (const bf16*)(ws + O_GM), (bf16*)(ws + O_GMX)};
          run_gemm(lds, (const bf16*)(ws + O_AO), (const bf16*)(ws + O_WMO), ML, 1024, 512, G, bx, fb); }
    }
    grid.sync();
    if (PH_MASK & 256) {
        PH_BEGIN FRes f{p.x, mod + 2048, p.out};
        run_gemm(lds, (const bf16*)(ws + O_GMX), (const bf16*)(ws + O_WOUT), ML, 1024, 1024, G, bx, f);
    }
    grid.sync();
    if (PH_MASK & 512) { PH_BEGIN ln_pass(p.out, (float*)(ws + O_X1), p.ln1_g, p.ln1_b, (bf16*)(ws + O_H2), mod); }
    grid.sync();
    if (PH_MASK & 1024) {
        PH_BEGIN FGU f{(bf16*)(ws + O_H)};
        run_gemm(lds, (const bf16*)(ws + O_H2), (const bf16*)(ws + O_WGU), ML, NGU, 1024, G, bx, f);
    }
    grid.sync();
    if (PH_MASK & 2048) {
        PH_BEGIN FRes f{(const float*)(ws + O_X1), mod + 5120, p.out};
        run_gemm(lds, (const bf16*)(ws + O_H), (const bf16*)(ws + O_WDN), ML, 1024, DFF, G, bx, f);
    }
    grid.sync();
    if (PH_MASK & 4096) { PH_BEGIN ln_pass(p.out, p.out, p.ln2_g, p.ln2_b, nullptr, mod); }
#endif
}

extern "C" void kernel_launch(void* const* d_in, const int* in_sizes, int n_in, void* d_out, int out_size, void* d_ws, size_t ws_size, hipStream_t stream) {
    static int grid = 0;
    if (grid == 0) {
        if (n_in != 22 || out_size != ML * DM || ws_size < WS_NEED) { fprintf(stderr, "kernel_launch: unexpected shapes (n_in %d out %d ws %zu)\n", n_in, out_size, ws_size); grid = -1; return; }
        int dev = 0, cus = 0, per_cu = 0;
        (void)hipGetDevice(&dev); (void)hipDeviceGetAttribute(&cus, hipDeviceAttributeMultiprocessorCount, dev);
        if (hipFuncSetAttribute((const void*)fwd_kernel, hipFuncAttributeMaxDynamicSharedMemorySize, LDS_BYTES) != hipSuccess) { fprintf(stderr, "kernel_launch: hipFuncSetAttribute failed\n"); grid = -1; return; }
        if (hipOccupancyMaxActiveBlocksPerMultiprocessor(&per_cu, (const void*)fwd_kernel, 512, LDS_BYTES) != hipSuccess || per_cu < 1) { fprintf(stderr, "kernel_launch: occupancy query says %d\n", per_cu); per_cu = 1; }
        (void)hipGetLastError();
        grid = cus;
    }
    if (grid < 0) return;
    Params p{};
    const float** pp = (const float**)&p;
    for (int i = 0; i < 22; ++i) pp[i] = (const float*)d_in[i];
    p.out = (float*)d_out; p.ws = (unsigned char*)d_ws;
    void* args[] = {&p};
    hipError_t e = hipLaunchCooperativeKernel((const void*)fwd_kernel, dim3(grid), dim3(512), args, LDS_BYTES, stream);
    if (e != hipSuccess) fprintf(stderr, "cooperative launch failed: %s (grid %d)\n", hipGetErrorString(e), grid);
}
```

```cpp
#include <hip/hip_runtime.h>
#include <hip/hip_cooperative_groups.h>
#include <cstdio>
#include <cstdint>
namespace cg = cooperative_groups;
namespace pg8 {
#define PG8_LAS __attribute__((address_space(3)))
typedef unsigned short bf16_t;
typedef short bf16x8 __attribute__((ext_vector_type(8)));
typedef float f32x4 __attribute__((ext_vector_type(4)));
typedef unsigned u32x4 __attribute__((ext_vector_type(4)));
constexpr int BM = 256, BK = 64, HALF = 128, HTB = HALF * BK * 2  , STAGE_BYTES = 8 * HTB, NXCD = 8, WGM = 8;

__host__ __device__ __forceinline__ int lds_byte(int r, int c) { const int st = (r >> 4) * 2 + (c >> 5), rr = r & 15, cc = c & 31, ob = rr * 64 + cc * 2; return st * 1024 + (ob ^ (((ob >> 9) & 1) << 5)); }
__host__ __device__ __forceinline__ void stage_rc(int b, int& R, int& C) { const int st = b / 1024, sb = b % 1024, swz = sb ^ (((sb >> 9) & 1) << 5); R = (st >> 1) * 16 + swz / 64; C = (st & 1) * 32 + (swz % 64) / 2; }
__host__ __device__ __forceinline__ int perm32(int rho) { const int n = rho >> 4, i = rho & 15; return 8 * (i >> 2) + 4 * n + (i & 3); }

struct Unit { int pm, pn; };
struct Gemm { const bf16_t* A; const bf16_t* Bt; int M, N, K; };

struct StaticOrder {
    int nM, nN, nwg, G, c;
    __host__ __device__ void init(int M, int N, int G_, int c_) { nM = M / BM; nN = N / BM; nwg = nM * nN; G = G_; c = c_; }
    __host__ __device__ bool next(int i, Unit& u) const {
        const long L = (long)i * G + c; if (L >= nwg) return false;
        int wgid = (int)L; { const int q = nwg / NXCD, r = nwg % NXCD, xcd = wgid % NXCD, off = wgid / NXCD; wgid = (xcd < r ? xcd * (q + 1) : r * (q + 1) + (xcd - r) * q) + off; }
        const int nig = WGM * nN, gid = wgid / nig, fm = gid * WGM, gsz = (nM - fm) < WGM ? (nM - fm) : WGM;
        u.pm = fm + ((wgid % nig) % gsz); u.pn = (wgid % nig) / gsz; return true;
    }
    __device__ __forceinline__ void a_ready(const Unit&) const {}
    __device__ __forceinline__ void done(const Unit&) const {}
};

__device__ __forceinline__ unsigned cvt_pk_bf16(float lo, float hi) { unsigned r; asm volatile("v_cvt_pk_bf16_f32 %0, %1, %2" : "=v"(r) : "v"(lo), "v"(hi)); return r; }
typedef float f32x2 __attribute__((ext_vector_type(2)));
template <class Epi, class Sched, bool ALIGN_EPI = false, bool SP2 = false>
__device__ __forceinline__ void gemm_phase(PG8_LAS unsigned char* lds, const Gemm g, const Sched& S, const Epi& E) {
    int tid_l = threadIdx.x; asm volatile("" : "+v"(tid_l));
    const int tid = tid_l, wid = __builtin_amdgcn_readfirstlane(tid >> 6), lane = tid & 63, wr = wid >> 2, wc = wid & 3, fr = lane & 15, fq = lane >> 4;
    const int K = g.K, nt = K / BK;
    unsigned voffA[2], voffB[2];
#pragma unroll
    for (int i = 0; i < 2; ++i) { int R, C; stage_rc(tid * 16 + i * 8192, R, C); const int Rb = Epi::PERM ? ((R & ~31) + perm32(R & 31)) : R;
        voffA[i] = (unsigned)(R * K + C) * 2u; voffB[i] = (unsigned)(Rb * K + C) * 2u; }
    const size_t kstep = (size_t)(BK * 2);
    const size_t hstep = (size_t)HALF * K * 2;
    const size_t tstep = 2 * hstep;
    const unsigned ldsw = (unsigned)wid * 1024u;
    const int aoff = lds_byte(wr * 64 + fr, fq * 8), boff = lds_byte(wc * 32 + fr, fq * 8);
#define PG8_SA(b, h) (((b) * 2 + (h)) * HTB)
#define PG8_SB(b, h) ((4 + (b) * 2 + (h)) * HTB)
#define PG8_STAGE(bufoff, gbase, voff) do { _Pragma("unroll") for (int _i = 0; _i < 2; ++_i) \
        __builtin_amdgcn_global_load_lds((const unsigned*)((const char*)(gbase) + (voff)[_i]), (PG8_LAS unsigned*)(lds + (bufoff) + ldsw + _i * 8192), 16, 0, 0); } while (0)
#define PG8_LDA(dst, b, h) do { _Pragma("unroll") for (int m = 0; m < 4; ++m) _Pragma("unroll") for (int k = 0; k < 2; ++k) dst[m][k] = *(const PG8_LAS bf16x8*)(lds + PG8_SA(b, h) + aoff + m * 2048 + k * 1024); } while (0)
#define PG8_LDB(dst, b, h) do { _Pragma("unroll") for (int n = 0; n < 2; ++n) _Pragma("unroll") for (int k = 0; k < 2; ++k) dst[n][k] = *(const PG8_LAS bf16x8*)(lds + PG8_SB(b, h) + boff + n * 2048 + k * 1024); } while (0)
#define PG8_MMA(ai, bj, At, Bt) do { __builtin_amdgcn_s_setprio(1); _Pragma("unroll") for (int m = 0; m < 4; ++m) _Pragma("unroll") for (int n = 0; n < 2; ++n) _Pragma("unroll") for (int k = 0; k < 2; ++k) \
        acc[ai][bj][m][n] = __builtin_amdgcn_mfma_f32_16x16x32_bf16(Bt[n][k], At[m][k], acc[ai][bj][m][n], 0, 0, 0); __builtin_amdgcn_s_setprio(0); } while (0)
#define PG8_WAIT_V(n) asm volatile("s_waitcnt vmcnt(" #n ")" ::: "memory")
#define PG8_WAIT_L(n) asm volatile("s_waitcnt lgkmcnt(" #n ")" ::: "memory")
#define PG8_BAR __builtin_amdgcn_s_barrier()
#define PG8_SCHED __builtin_amdgcn_sched_barrier(0)
    Unit cur, nxt; int ui = 0;
    if (!S.next(0, cur)) return;
    f32x4 acc[2][2][4][2];
#pragma unroll
    for (int a = 0; a < 2; ++a)
#pragma unroll
        for (int b = 0; b < 2; ++b)
#pragma unroll
            for (int m = 0; m < 4; ++m)
#pragma unroll
                for (int n = 0; n < 2; ++n) acc[a][b][m][n] = (f32x4){0.f, 0.f, 0.f, 0.f};
    bf16x8 At[4][2], B0[2][2], B1[2][2];
    const char* cA = (const char*)g.A + (size_t)cur.pm * tstep; const char* cB = (const char*)g.Bt + (size_t)cur.pn * tstep;
    S.a_ready(cur);
    if constexpr (SP2) {
        PG8_STAGE(PG8_SB(0, 0), cB, voffB); PG8_STAGE(PG8_SB(0, 1), cB + hstep, voffB); PG8_STAGE(PG8_SA(0, 0), cA, voffA); PG8_STAGE(PG8_SA(0, 1), cA + hstep, voffA);
        if (wr == 1) PG8_BAR;
        PG8_WAIT_V(2); PG8_BAR;
        PG8_STAGE(PG8_SB(1, 0), cB + kstep, voffB); PG8_STAGE(PG8_SA(1, 0), cA + kstep, voffA); PG8_STAGE(PG8_SB(1, 1), cB + hstep + kstep, voffB);
        PG8_WAIT_V(6); PG8_BAR;
    } else {
        PG8_STAGE(PG8_SB(0, 0), cB, voffB); PG8_STAGE(PG8_SA(0, 0), cA, voffA); PG8_STAGE(PG8_SB(0, 1), cB + hstep, voffB); PG8_STAGE(PG8_SA(0, 1), cA + hstep, voffA);
        if (wr == 1) PG8_BAR;
        PG8_WAIT_V(4); PG8_BAR;
        PG8_STAGE(PG8_SB(1, 0), cB + kstep, voffB); PG8_STAGE(PG8_SA(1, 0), cA + kstep, voffA); PG8_STAGE(PG8_SB(1, 1), cB + hstep + kstep, voffB);
        PG8_WAIT_V(6); PG8_BAR;
    }
    for (;;) {
        const bool has_next = S.next(ui + 1, nxt);
        const char* nA = has_next ? (const char*)g.A + (size_t)nxt.pm * tstep : cA; const char* nB = has_next ? (const char*)g.Bt + (size_t)nxt.pn * tstep : cB;
        for (int t = 0; t < nt; t += 2) {
            const bool last = (t == nt - 2);
            const char* a1 = cA + (size_t)(t + 1) * kstep;
            const char* a2 = last ? nA : cA + (size_t)(t + 2) * kstep; const char* b2 = last ? nB : cB + (size_t)(t + 2) * kstep;
            const char* a3 = a2 + kstep; const char* b3 = b2 + kstep;
            if (last && has_next) S.a_ready(nxt);
            if constexpr (SP2) {
            PG8_LDB(B0, 0, 0); PG8_LDB(B1, 0, 1); PG8_SCHED; PG8_LDA(At, 0, 0); PG8_STAGE(PG8_SA(1, 1), a1 + hstep, voffA);
            PG8_WAIT_V(8); PG8_WAIT_L(0); PG8_BAR; PG8_MMA(0, 0, At, B0); PG8_MMA(0, 1, At, B1); PG8_BAR; PG8_SCHED;
            PG8_LDA(At, 0, 1); PG8_STAGE(PG8_SB(0, 0), b2, voffB); PG8_STAGE(PG8_SB(0, 1), b2 + hstep, voffB); PG8_STAGE(PG8_SA(0, 0), a2, voffA);
            PG8_WAIT_V(8); PG8_WAIT_L(0); PG8_BAR; PG8_MMA(1, 0, At, B0); PG8_MMA(1, 1, At, B1); PG8_BAR; PG8_SCHED;
            PG8_LDB(B0, 1, 0); PG8_LDB(B1, 1, 1); PG8_SCHED; PG8_LDA(At, 1, 0); PG8_STAGE(PG8_SA(0, 1), a2 + hstep, voffA);
            PG8_WAIT_V(8); PG8_WAIT_L(0); PG8_BAR; PG8_MMA(0, 0, At, B0); PG8_MMA(0, 1, At, B1); PG8_BAR; PG8_SCHED;
            PG8_LDA(At, 1, 1); PG8_STAGE(PG8_SB(1, 0), b3, voffB); PG8_STAGE(PG8_SB(1, 1), b3 + hstep, voffB); PG8_STAGE(PG8_SA(1, 0), a3, voffA);
            PG8_WAIT_V(8); PG8_WAIT_L(0); PG8_BAR; PG8_MMA(1, 0, At, B0); PG8_MMA(1, 1, At, B1); PG8_BAR; PG8_SCHED;
            } else {
            PG8_LDB(B0, 0, 0); PG8_SCHED; PG8_LDA(At, 0, 0); PG8_STAGE(PG8_SA(1, 1), a1 + hstep, voffA);
            PG8_WAIT_L(8); PG8_BAR; PG8_WAIT_L(0); PG8_MMA(0, 0, At, B0); PG8_BAR; PG8_SCHED;
            PG8_LDB(B1, 0, 1); PG8_STAGE(PG8_SB(0, 0), b2, voffB);
            PG8_BAR; PG8_WAIT_L(0); PG8_MMA(0, 1, At, B1); PG8_BAR;
            PG8_LDA(At, 0, 1); PG8_STAGE(PG8_SA(0, 0), a2, voffA);
            PG8_BAR; PG8_WAIT_L(0); PG8_MMA(1, 0, At, B0); PG8_BAR; PG8_SCHED;
            PG8_STAGE(PG8_SB(0, 1), b2 + hstep, voffB);
            PG8_WAIT_V(6); PG8_BAR; PG8_MMA(1, 1, At, B1); PG8_BAR;
            PG8_LDB(B0, 1, 0); PG8_SCHED; PG8_LDA(At, 1, 0); PG8_STAGE(PG8_SA(0, 1), a2 + hstep, voffA);
            PG8_WAIT_L(8); PG8_BAR; PG8_WAIT_L(0); PG8_MMA(0, 0, At, B0); PG8_BAR; PG8_SCHED;
            PG8_LDB(B1, 1, 1); PG8_STAGE(PG8_SB(1, 0), b3, voffB);
            PG8_BAR; PG8_WAIT_L(0); PG8_MMA(0, 1, At, B1); PG8_BAR;
            PG8_LDA(At, 1, 1); PG8_STAGE(PG8_SA(1, 0), a3, voffA);
            PG8_BAR; PG8_WAIT_L(0); PG8_MMA(1, 0, At, B0); PG8_BAR; PG8_SCHED;
            PG8_STAGE(PG8_SB(1, 1), b3 + hstep, voffB);
            PG8_WAIT_V(6); PG8_BAR; PG8_MMA(1, 1, At, B1); PG8_BAR;
            }
        }
        if constexpr (ALIGN_EPI) { if (wr == 0) PG8_BAR; }
        if constexpr (!Epi::AFTER_DRAIN) { E(acc, cur, wr, wc, fr, fq); S.done(cur); }
        if (!has_next) break;
#pragma unroll
        for (int a = 0; a < 2; ++a)
#pragma unroll
            for (int b = 0; b < 2; ++b)
#pragma unroll
                for (int m = 0; m < 4; ++m)
#pragma unroll
                    for (int n = 0; n < 2; ++n) acc[a][b][m][n] = (f32x4){0.f, 0.f, 0.f, 0.f};
        cur = nxt; cA = nA; cB = nB; ++ui;
        if constexpr (ALIGN_EPI) { if (wr == 1) PG8_BAR; }
    }
    PG8_WAIT_V(0);
    if constexpr (!ALIGN_EPI) { if (wr == 0) PG8_BAR; }
    PG8_BAR;
    if constexpr (Epi::AFTER_DRAIN) { E.fused(acc, cur, wr, wc, fr, fq, lds, wid, lane); S.done(cur); }
#undef PG8_SA
#undef PG8_SB
#undef PG8_STAGE
#undef PG8_LDA
#undef PG8_LDB
#undef PG8_MMA
#undef PG8_WAIT_V
#undef PG8_WAIT_L
#undef PG8_BAR
#undef PG8_SCHED
}
}

#define LAS __attribute__((address_space(3)))
#define DI __device__ __forceinline__
typedef unsigned short bf16;
typedef short bf16x8 __attribute__((ext_vector_type(8)));
typedef short s16x4 __attribute__((ext_vector_type(4)));
typedef short v4i16_t __attribute__((ext_vector_type(4)));
typedef float f32x4 __attribute__((ext_vector_type(4)));
typedef float f32x16 __attribute__((ext_vector_type(16)));
typedef unsigned u32x4 __attribute__((ext_vector_type(4)));
typedef unsigned u32x2 __attribute__((ext_vector_type(2)));
typedef float f32x2_t __attribute__((ext_vector_type(2)));
typedef __bf16 bf16x2_t __attribute__((ext_vector_type(2)));
#define MFMA32(a, b, c) __builtin_amdgcn_mfma_f32_32x32x16_bf16((a), (b), (c), 0, 0, 0)

constexpr int DM = 1024, NBAT = 4, SEQ = 4096, CTX = 256, ML = NBAT * SEQ, MC = NBAT * CTX, MT = ML + MC, KEYS = CTX + SEQ;
constexpr int NIN = 5888, INW = 5792, DFF = 2816, NGU = 5632;
constexpr size_t MiB = 1u << 20;
constexpr size_t O_WGU = 0, O_WDN = O_WGU + (size_t)NGU * 1024 * 2, O_WOUT = O_WDN + (size_t)1024 * DFF * 2, O_WRO = O_WOUT + 2 * MiB, O_WMO = O_WRO + 2 * MiB,
                 O_WUQ = O_WMO + 1 * MiB, O_WUKV = O_WUQ + 768 * 384 * 2, O_MOD = O_WUKV + 1024 * 256 * 2, O_T1 = O_MOD + 5 * 6144 * 4, O_T2 = O_T1 + 4096 * 64 * 8,
                 O_SS = O_T2 + 64 * 8 * 8, O_MISC_END = O_SS + (size_t)MT * 24 * 4;
static_assert(O_MISC_END <= 27 * MiB, "misc region");
constexpr size_t O_RQ = 27 * MiB, O_RK = 43 * MiB, O_RV = 60 * MiB, O_RG = 94 * MiB, O_GR = 126 * MiB, O_GM = 158 * MiB, O_DQ = 190 * MiB, O_DKV = 202 * MiB,
                 O_WING = 211 * MiB, O_WINM = 217 * MiB, O_OC = 217 * MiB, O_KR = 254 * MiB, O_AO = 190 * MiB, O_GMX = 27 * MiB, O_X1 = 94 * MiB, O_H2 = 59 * MiB, O_H = 158 * MiB,
                 WS_NEED = 256 * MiB;
constexpr size_t OO_QM = 0, OO_KN = 24 * MiB, OO_VN = 41 * MiB;
constexpr int LDS_BYTES = 147456;
constexpr float ALPHA = 1.189207115002721f;
constexpr float LN_EPS = 1e-5f, RMS_EPS = 1e-6f;
constexpr float QSCALE = 0.10206207261596575f * 1.4426950408889634f;
constexpr float KSCALE = 0.08838834764831845f;

struct Params {
    const float *x, *c, *ctx, *c_ctx, *w_ada, *b_ada, *w_in, *dec_f, *dec_b, *w_ret_o, *q_norm, *w_uq, *kv_norm, *w_ukv, *w_mla_o, *w_out, *ln1_g, *ln1_b, *w_gu, *w_down, *ln2_g, *ln2_b;
    float* out; unsigned char* ws;
};

DI unsigned cvtpk(float lo, float hi) { f32x2_t v = {lo, hi}; bf16x2_t b = __builtin_convertvector(v, bf16x2_t); return __builtin_bit_cast(unsigned, b); }
DI float bflo(unsigned u) { return __uint_as_float(u << 16); }
DI float bfhi(unsigned u) { return __uint_as_float(u & 0xffff0000u); }
DI float bf2f(bf16 v) { return __uint_as_float(((unsigned)v) << 16); }
DI bf16 f2bf(float f) { return (bf16)(cvtpk(f, 0.f) & 0xffffu); }
DI u32x4 pack8(const float (&v)[8]) { u32x4 w; w.x = cvtpk(v[0], v[1]); w.y = cvtpk(v[2], v[3]); w.z = cvtpk(v[4], v[5]); w.w = cvtpk(v[6], v[7]); return w; }
DI void unpack8(u32x4 w, float (&v)[8]) { v[0] = bflo(w.x); v[1] = bfhi(w.x); v[2] = bflo(w.y); v[3] = bfhi(w.y); v[4] = bflo(w.z); v[5] = bfhi(w.z); v[6] = bflo(w.w); v[7] = bfhi(w.w); }
DI float fexp2(float x) { return __builtin_amdgcn_exp2f(x); }
DI float silu_f(float v) { return v / (1.f + __expf(-v)); }
DI float sigm_f(float v) { return 1.f / (1.f + __expf(-v)); }
DI s16x4 trr(unsigned addr) { return __builtin_bit_cast(s16x4, __builtin_amdgcn_ds_read_tr16_b64_v4i16((LAS v4i16_t*)addr)); }
DI bf16x8 cat4(s16x4 lo, s16x4 hi) { return __builtin_shufflevector(lo, hi, 0, 1, 2, 3, 4, 5, 6, 7); }
DI int crow(int reg, int h) { return (reg & 3) + 8 * (reg >> 2) + 4 * h; }
DI bf16x8 packstep(const f32x16& x, int s) { u32x4 p; p.x = cvtpk(x[8 * s], x[8 * s + 1]); p.y = cvtpk(x[8 * s + 2], x[8 * s + 3]); p.z = cvtpk(x[8 * s + 4], x[8 * s + 5]); p.w = cvtpk(x[8 * s + 6], x[8 * s + 7]); return __builtin_bit_cast(bf16x8, p); }
DI float wave_sum(float v) {
#pragma unroll
    for (int o = 1; o < 64; o <<= 1) v += __shfl_xor(v, o);
    return v;
}

template <class F> struct EpiG {
    static constexpr bool PERM = true, AFTER_DRAIN = false;
    F f; int pn_off;
    __device__ __forceinline__ void operator()(const pg8::f32x4 (&acc)[2][2][4][2], const pg8::Unit& u, int wr_, int wc_, int fr_, int fq_) const {
        int t_ = threadIdx.x; asm volatile("" : "+v"(t_));
        const int wid_ = __builtin_amdgcn_readfirstlane(t_ >> 6), wr = wid_ >> 2, wc = wid_ & 3, fr = t_ & 15, fq = (t_ >> 4) & 3;
#pragma unroll
        for (int ai = 0; ai < 2; ++ai)
#pragma unroll
            for (int m = 0; m < 4; ++m) {
                const int row = u.pm * 256 + ai * 128 + wr * 64 + m * 16 + fr;
#pragma unroll
                for (int bj = 0; bj < 2; ++bj) {
                    const int col0 = (u.pn + pn_off) * 256 + bj * 128 + wc * 32 + 8 * fq;
                    float v[8];
#pragma unroll
                    for (int j = 0; j < 4; ++j) { v[j] = acc[ai][bj][m][0][j]; v[4 + j] = acc[ai][bj][m][1][j]; }
                    f(row, col0, v, u.pn + pn_off);
                    asm volatile("" ::: "memory");
                }
            }
    }
};

struct FIn {
    bf16 *RQ, *RK, *RV, *RG, *GR, *GM, *DQ, *DKV, *KR; float* SS; const float* T1; const float* T2;
    DI void rope4(float (&v)[8], const float* cs) const {
        const f32x4 a = *(const f32x4*)cs, b = *(const f32x4*)(cs + 4);
        const float c0 = a[0], s0 = a[1], c1 = a[2], s1 = a[3], c2 = b[0], s2 = b[1], c3 = b[2], s3 = b[3];
        float t;
        t = v[0] * c0 - v[1] * s0; v[1] = v[1] * c0 + v[0] * s0; v[0] = t;
        t = v[2] * c1 - v[3] * s1; v[3] = v[3] * c1 + v[2] * s1; v[2] = t;
        t = v[4] * c2 - v[5] * s2; v[5] = v[5] * c2 + v[4] * s2; v[4] = t;
        t = v[6] * c3 - v[7] * s3; v[7] = v[7] * c3 + v[6] * s3; v[6] = t;
    }
    DI void operator()(int row, int col0, float (&v)[8], int pn) const {
        const bool lat = row < ML;
        if (pn < 4) {
            if (lat) { const int pos = row & (SEQ - 1), i0 = (col0 & 127) >> 1; rope4(v, T1 + ((size_t)pos * 64 + i0) * 2); }
            if (pn < 2) { if (lat) *(u32x4*)(RQ + (size_t)row * 512 + col0) = pack8(v); }
            else {
#pragma unroll
                for (int j = 0; j < 8; ++j) v[j] *= KSCALE;
                *(u32x4*)(RK + (size_t)row * 512 + (col0 - 512)) = pack8(v);
            }
        } else if (pn < 8) {
            *(u32x4*)(RV + (size_t)row * 1024 + (col0 - 1024)) = pack8(v);
        } else if (pn >= 11 && pn < 15) {
            if (lat) {
#pragma unroll
                for (int j = 0; j < 8; ++j) v[j] = silu_f(v[j]);
                *(u32x4*)(RG + (size_t)row * 1024 + (col0 - 2816)) = pack8(v); }
        } else if (pn >= 15) {
            if (lat) {
#pragma unroll
                for (int j = 0; j < 8; ++j) v[j] = sigm_f(v[j]);
                bf16* dst = pn < 19 ? GR + (size_t)row * 1024 + (col0 - 3840) : GM + (size_t)row * 1024 + (col0 - 4864);
                *(u32x4*)dst = pack8(v); }
        } else {
            float s = 0.f;
#pragma unroll
            for (int j = 0; j < 8; ++j) s += v[j] * v[j];
            s += __shfl_xor(s, 16); s += __shfl_xor(s, 32);
            const int c = col0 - 2048;
            if ((threadIdx.x & 63) < 16) SS[(size_t)row * 24 + (c >> 5)] = s;
            if (c < 384) { if (lat) *(u32x4*)(DQ + (size_t)row * 384 + c) = pack8(v); }
            else if (c < 640) { *(u32x4*)(DKV + (size_t)row * 256 + (c - 384)) = pack8(v); }
            else if (c < 672) {
                const int r = c - 640;
                int b, key;
                if (lat) { b = row >> 12; key = CTX + (row & (SEQ - 1)); const int t = row & (SEQ - 1); const int p = (r < 16) ? (t >> 6) : (t & 63); const int i0 = (r & 15) >> 1; rope4(v, T2 + (p * 8 + i0) * 2); }
                else { b = (row - ML) >> 8; key = (row - ML) & 255; }
                *(u32x4*)(KR + ((size_t)b * KEYS + key) * 32 + r) = pack8(v);
            }
        }
    }
};
struct FQ {
    bf16* QM; const float* SS; const float* T2;
    DI void operator()(int row, int col0, float (&v)[8], int) const {
        const f32x4 a = *(const f32x4*)(SS + (size_t)row * 24), b = *(const f32x4*)(SS + (size_t)row * 24 + 4), c = *(const f32x4*)(SS + (size_t)row * 24 + 8);
        const float ss = ((a[0] + a[1]) + (a[2] + a[3])) + ((b[0] + b[1]) + (b[2] + b[3])) + ((c[0] + c[1]) + (c[2] + c[3]));
        const float sc = rsqrtf(ss * (1.f / 384.f) + RMS_EPS) * QSCALE;
#pragma unroll
        for (int j = 0; j < 8; ++j) v[j] *= sc;
        const int h = col0 / 96, d0 = col0 - 96 * h, bb = row >> 12, t = row & (SEQ - 1);
        if (d0 >= 64) {
            const int r = d0 - 64; const int p = (r < 16) ? (t >> 6) : (t & 63); const int i0 = (r & 15) >> 1;
            const float* cs = T2 + (p * 8 + i0) * 2;
            const f32x4 ca = *(const f32x4*)cs, cb = *(const f32x4*)(cs + 4);
            float tt;
            tt = v[0] * ca[0] - v[1] * ca[1]; v[1] = v[1] * ca[0] + v[0] * ca[1]; v[0] = tt;
            tt = v[2] * ca[2] - v[3] * ca[3]; v[3] = v[3] * ca[2] + v[2] * ca[3]; v[2] = tt;
            tt = v[4] * cb[0] - v[5] * cb[1]; v[5] = v[5] * cb[0] + v[4] * cb[1]; v[4] = tt;
            tt = v[6] * cb[2] - v[7] * cb[3]; v[7] = v[7] * cb[2] + v[6] * cb[3]; v[6] = tt;
        }
        *(u32x4*)(QM + ((size_t)(bb * 8 + h) * SEQ + t) * 96 + d0) = pack8(v);
    }
};
struct FKV {
    bf16 *KN, *VN; const float* SS;
    DI void operator()(int row, int col0, float (&v)[8], int) const {
        const f32x4 a = *(const f32x4*)(SS + (size_t)row * 24 + 12), b = *(const f32x4*)(SS + (size_t)row * 24 + 16);
        const float ss = ((a[0] + a[1]) + (a[2] + a[3])) + ((b[0] + b[1]) + (b[2] + b[3]));
        const float sc = rsqrtf(ss * (1.f / 256.f) + RMS_EPS);
#pragma unroll
        for (int j = 0; j < 8; ++j) v[j] *= sc;
        int bb, key;
        if (row < ML) { bb = row >> 12; key = CTX + (row & (SEQ - 1)); } else { bb = (row - ML) >> 8; key = (row - ML) & 255; }
        const int h = col0 >> 7, r = col0 & 127;
        bf16* dst = (r < 64) ? KN + ((size_t)(bb * 8 + h) * KEYS + key) * 64 + r : VN + ((size_t)(bb * 8 + h) * KEYS + key) * 64 + (r - 64);
        *(u32x4*)dst = pack8(v);
    }
};
struct F5a { float* T; const bf16* GR;
    DI void operator()(int row, int col0, float (&v)[8], int) const {
        float g[8]; unpack8(*(const u32x4*)(GR + (size_t)row * 1024 + col0), g);
        f32x4 o0, o1;
#pragma unroll
        for (int j = 0; j < 4; ++j) { o0[j] = g[j] * v[j]; o1[j] = g[4 + j] * v[4 + j]; }
        *(f32x4*)(T + (size_t)row * 1024 + col0) = o0; *(f32x4*)(T + (size_t)row * 1024 + col0 + 4) = o1;
    } };
struct F5b { const float* T; const bf16* GM; bf16* O;
    DI void operator()(int row, int col0, float (&v)[8], int) const {
        float g[8]; unpack8(*(const u32x4*)(GM + (size_t)row * 1024 + col0), g);
        const f32x4 t0 = *(const f32x4*)(T + (size_t)row * 1024 + col0), t1 = *(const f32x4*)(T + (size_t)row * 1024 + col0 + 4);
        float o[8];
#pragma unroll
        for (int j = 0; j < 4; ++j) { o[j] = t0[j] + g[j] * v[j]; o[4 + j] = t1[j] + g[4 + j] * v[4 + j]; }
        *(u32x4*)(O + (size_t)row * 1024 + col0) = pack8(o);
    } };
struct FRes { const float* base; const float* gate  ; float* O;
    DI void operator()(int row, int col0, float (&v)[8], int) const {
        const int bb = row >> 12;
        const f32x4 x0 = *(const f32x4*)(base + (size_t)row * 1024 + col0), x1 = *(const f32x4*)(base + (size_t)row * 1024 + col0 + 4);
        const f32x4 g0 = *(const f32x4*)(gate + bb * 6144 + col0), g1 = *(const f32x4*)(gate + bb * 6144 + col0 + 4);
        f32x4 o0, o1;
#pragma unroll
        for (int j = 0; j < 4; ++j) { o0[j] = ALPHA * x0[j] + g0[j] * v[j]; o1[j] = ALPHA * x1[j] + g1[j] * v[4 + j]; }
        *(f32x4*)(O + (size_t)row * 1024 + col0) = o0; *(f32x4*)(O + (size_t)row * 1024 + col0 + 4) = o1;
    } };
struct FGU { bf16* H;
    DI void operator()(int row, int col0, float (&v)[8], int) const {
        u32x2 w; w.x = cvtpk(silu_f(v[0]) * v[1], silu_f(v[2]) * v[3]); w.y = cvtpk(silu_f(v[4]) * v[5], silu_f(v[6]) * v[7]);
        *(u32x2*)(H + (size_t)row * DFF + (col0 >> 1)) = w;
    } };

DI int mapcol(int kind, int p) {
    switch (kind) {
    case 0: {
        if (p < 1024) { const int base = (p < 512) ? 0 : 512; const int q = p - base; const int h = q >> 7, r = q & 127; return base + h * 128 + (r >> 1) + 64 * (r & 1); }
        if (p < 2048) return p;
        if (p < 2816) { const int c = p - 2048;
            if (c < 384) return 3072 + c;
            if (c < 640) return 3456 + (c - 384);
            if (c < 672) { const int r = c - 640; const int g = r >> 4, rr = r & 15; return 3712 + 16 * g + (rr >> 1) + 8 * (rr & 1); }
            return -1; }
        if (p < 3840) return 2048 + (p - 2816);
        if (p < 4864) return 3744 + (p - 3840);
        return 4768 + (p - 4864);
        return -1; }
    case 1: return (p & 1) * DFF + (p >> 1);
    case 2: {
        const int h = p / 96, d = p - 96 * h; if (d < 64) return p; const int r = d - 64; const int g = r >> 4, rr = r & 15; return h * 96 + 64 + 16 * g + (rr >> 1) + 8 * (rr & 1); }
    default: return p;
    }
}
DI void tr_item(const float* W, int Nsrc, int K, bf16* WT, const float* rowscale, LAS float* scr, int item, int nblk, int lane, int kind) {
    const int kb = item / nblk, nb = item - kb * nblk, k0 = 64 * kb, n0 = 32 * nb;
    const int src = mapcol(kind, n0 + (lane & 31));
#pragma unroll 8
    for (int i = 0; i < 32; ++i) { const int kk = 2 * i + (lane >> 5); float v = (src >= 0) ? W[(size_t)(k0 + kk) * Nsrc + src] : 0.f; if (rowscale) v *= rowscale[k0 + kk]; scr[kk * 33 + (lane & 31)] = v; }
    asm volatile("s_waitcnt lgkmcnt(0)" ::: "memory");
    const int c = lane & 7;
#pragma unroll
    for (int j = 0; j < 4; ++j) { const int n = (lane >> 3) + 8 * j; const LAS float* s = scr + (8 * c) * 33 + n;
        u32x4 o; o.x = cvtpk(s[0 * 33], s[1 * 33]); o.y = cvtpk(s[2 * 33], s[3 * 33]); o.z = cvtpk(s[4 * 33], s[5 * 33]); o.w = cvtpk(s[6 * 33], s[7 * 33]);
        *(u32x4*)(WT + (size_t)(n0 + n) * K + k0 + 8 * c) = o; }
    asm volatile("s_waitcnt lgkmcnt(0)" ::: "memory");
}
DI void phase0(const Params& p, LAS unsigned char* lds) {
    int tid_ = threadIdx.x; asm volatile("" : "+v"(tid_));
    int G_ = gridDim.x, bx_ = blockIdx.x; asm volatile("" : "+s"(G_), "+s"(bx_));
    const int tid = tid_, lane = tid & 63, wave = tid >> 6, G = G_;
    unsigned char* ws = p.ws;
    {
        LAS float* sm = (LAS float*)lds; LAS float* part = sm + 5120;
        for (int cgp = bx_; cgp < 192; cgp += G) {
            for (int i = tid; i < 5120; i += 512) { const float v = (i < 4096) ? p.c[i] : p.c_ctx[i - 4096]; sm[i] = v / (1.f + expf(-v)); }
            __syncthreads();
            const int cq = tid & 7, ks = tid >> 3, col = cgp * 32 + cq * 4;
            float acc[5][4];
#pragma unroll
            for (int r = 0; r < 5; ++r)
#pragma unroll
                for (int j = 0; j < 4; ++j) acc[r][j] = 0.f;
#pragma unroll 4
            for (int kk = 0; kk < 16; ++kk) { const int k = ks * 16 + kk; const f32x4 w = *(const f32x4*)(p.w_ada + (size_t)k * 6144 + col);
#pragma unroll
                for (int r = 0; r < 5; ++r) { const float s = sm[r * 1024 + k];
#pragma unroll
                    for (int j = 0; j < 4; ++j) acc[r][j] += s * w[j]; } }
#pragma unroll
            for (int r = 0; r < 5; ++r)
#pragma unroll
                for (int j = 0; j < 4; ++j) part[(ks * 5 + r) * 32 + cq * 4 + j] = acc[r][j];
            __syncthreads();
            if (tid < 160) { const int r = tid >> 5, cc = tid & 31; float s = 0.f; for (int k2 = 0; k2 < 64; ++k2) s += part[(k2 * 5 + r) * 32 + cc];
                ((float*)(ws + O_MOD))[r * 6144 + cgp * 32 + cc] = s + p.b_ada[cgp * 32 + cc]; }
            __syncthreads();
        }
    }
    {
        LAS float* scr = (LAS float*)(lds + wave * 8704);
        const int gw = bx_ * 8 + wave, NGW = G * 8;
        constexpr int I0 = 16 * 184, I1 = 16 * 176, I2 = 44 * 32, I3 = 16 * 32, I4 = 16 * 32, I5 = 8 * 32, I6 = 6 * 24, I7 = 4 * 32;
        constexpr int NIT = I0 + I1 + I2 + I3 + I4 + I5 + I6 + I7;
        for (int it = gw; it < NIT; it += NGW) {
            int r = it;
            if (r < I0) { const int nb_ = r % 184; bf16* wt_ = (nb_ < 88) ? (bf16*)(ws + O_WINM) : (bf16*)(ws + O_WING) - (size_t)2816 * 1024; tr_item(p.w_in, INW, 1024, wt_, nullptr, scr, r, 184, lane, 0); continue; } r -= I0;
            if (r < I1) { tr_item(p.w_gu, NGU, 1024, (bf16*)(ws + O_WGU), nullptr, scr, r, 176, lane, 1); continue; } r -= I1;
            if (r < I2) { tr_item(p.w_down, 1024, DFF, (bf16*)(ws + O_WDN), nullptr, scr, r, 32, lane, 9); continue; } r -= I2;
            if (r < I3) { tr_item(p.w_ret_o, 1024, 1024, (bf16*)(ws + O_WRO), nullptr, scr, r, 32, lane, 9); continue; } r -= I3;
            if (r < I4) { tr_item(p.w_out, 1024, 1024, (bf16*)(ws + O_WOUT), nullptr, scr, r, 32, lane, 9); continue; } r -= I4;
            if (r < I5) { tr_item(p.w_mla_o, 1024, 512, (bf16*)(ws + O_WMO), nullptr, scr, r, 32, lane, 9); continue; } r -= I5;
            if (r < I6) { tr_item(p.w_uq, 768, 384, (bf16*)(ws + O_WUQ), p.q_norm, scr, r, 24, lane, 2); continue; } r -= I6;
            tr_item(p.w_ukv, 1024, 256, (bf16*)(ws + O_WUKV), p.kv_norm, scr, r, 32, lane, 9);
        }
    }
    {
        float* T1 = (float*)(ws + O_T1); float* T2 = (float*)(ws + O_T2);
        const int gt = bx_ * 512 + tid, NT = G * 512;
        for (int e = gt; e < 4096 * 64 + 64 * 8; e += NT) {
            float pos, fr; float* dst;
            if (e < 4096 * 64) { pos = (float)(e >> 6); fr = exp2f(-(float)(e & 63) * (13.287712379549449f / 64.f)); dst = T1 + 2 * e; }
            else { const int e2 = e - 4096 * 64; pos = (float)(e2 >> 3); fr = exp2f(-(float)(e2 & 7) * (13.287712379549449f / 8.f)); dst = T2 + 2 * e2; }
            const float ang = pos * fr;
            const double a = (double)ang; const double n = rint(a * 0.15915494309189535); const float rr = (float)(a - n * 6.283185307179586);
            dst[0] = cosf(rr); dst[1] = sinf(rr);
        }
    }
}
DI void phase1(const Params& p) {
    int tid_ = threadIdx.x; asm volatile("" : "+v"(tid_));
    int G_ = gridDim.x, bx_ = blockIdx.x; asm volatile("" : "+s"(G_), "+s"(bx_));
    const int lane = tid_ & 63, gw = bx_ * 8 + (tid_ >> 6), NGW = G_ * 8;
    const float* mod = (const float*)(p.ws + O_MOD);
    bf16* A1 = (bf16*)p.out;
    for (int m = gw; m < MT; m += NGW) {
        const float* xr; const float* md;
        if (m < ML) { xr = p.x + (size_t)m * 1024; md = mod + (m >> 12) * 6144; } else { xr = p.ctx + (size_t)(m - ML) * 1024; md = mod + 4 * 6144; }
#pragma unroll
        for (int j = 0; j < 4; ++j) { const int k = 4 * lane + 256 * j; const f32x4 v = *(const f32x4*)(xr + k), sh = *(const f32x4*)(md + k), sc = *(const f32x4*)(md + 1024 + k);
            u32x2 w; w.x = cvtpk(v[0] * (1.f + sc[0]) + sh[0], v[1] * (1.f + sc[1]) + sh[1]); w.y = cvtpk(v[2] * (1.f + sc[2]) + sh[2], v[3] * (1.f + sc[3]) + sh[3]);
            *(u32x2*)(A1 + (size_t)m * 1024 + k) = w; }
    }
}
DI void ln_pass(const float* V, float* Y, const float* g, const float* bta, bf16* H2, const float* mod) {
    int tid_ = threadIdx.x; asm volatile("" : "+v"(tid_));
    int G_ = gridDim.x, bx_ = blockIdx.x; asm volatile("" : "+s"(G_), "+s"(bx_));
    const int lane = tid_ & 63, gw = bx_ * 8 + (tid_ >> 6), NGW = G_ * 8;
    for (int m = gw; m < ML; m += NGW) {
        f32x4 v[4]; float s = 0.f;
#pragma unroll
        for (int j = 0; j < 4; ++j) { v[j] = *(const f32x4*)(V + (size_t)m * 1024 + 4 * lane + 256 * j); s += (v[j][0] + v[j][1]) + (v[j][2] + v[j][3]); }
        const float mean = wave_sum(s) * (1.f / 1024.f); float s2 = 0.f;
#pragma unroll
        for (int j = 0; j < 4; ++j) { v[j] = v[j] - mean; s2 += (v[j][0] * v[j][0] + v[j][1] * v[j][1]) + (v[j][2] * v[j][2] + v[j][3] * v[j][3]); }
        const float rstd = rsqrtf(wave_sum(s2) * (1.f / 1024.f) + LN_EPS);
        const float* md = mod + (m >> 12) * 6144;
#pragma unroll
        for (int j = 0; j < 4; ++j) { const int k = 4 * lane + 256 * j; const f32x4 gg = *(const f32x4*)(g + k), bb = *(const f32x4*)(bta + k);
            f32x4 y;
#pragma unroll
            for (int e = 0; e < 4; ++e) y[e] = v[j][e] * rstd * gg[e] + bb[e];
            *(f32x4*)(Y + (size_t)m * 1024 + k) = y;
            if (H2) { const f32x4 sh = *(const f32x4*)(md + 3072 + k), sc = *(const f32x4*)(md + 4096 + k);
                u32x2 w; w.x = cvtpk(y[0] * (1.f + sc[0]) + sh[0], y[1] * (1.f + sc[1]) + sh[1]); w.y = cvtpk(y[2] * (1.f + sc[2]) + sh[2], y[3] * (1.f + sc[3]) + sh[3]);
                *(u32x2*)(H2 + (size_t)m * 1024 + k) = w; } }
    }
}

constexpr int SC_KP = 272, SC_VP = 144, SC_K = 0, SC_V = 2 * 128 * SC_KP, SC_ST = SC_V + 2 * 128 * SC_VP, SC_END = SC_ST + 2 * 64 * SC_KP;
static_assert(SC_END <= LDS_BYTES, "scan lds");
DI void scan_item(const Params& p, LAS unsigned char* lds, int item) {
    int tid_ = threadIdx.x; asm volatile("" : "+v"(tid_));
    const int tid = tid_, lane = tid & 63, w = tid >> 6, rb = w >> 1, vb = w & 1, l31 = lane & 31, hh = lane >> 5;
    const int b = item >> 4, h = (item >> 2) & 3, dvs = item & 3;
    const bf16* RQ = (const bf16*)(p.ws + O_RQ); const bf16* RK = (const bf16*)(p.ws + O_RK); const bf16* RV = (const bf16*)(p.ws + O_RV);
    bf16* OC = (bf16*)(p.ws + O_OC);
    const unsigned ldsb = (unsigned)(size_t)lds;
    float lg2[2], gC[2];
    { const float df = p.dec_f[h], db = p.dec_b[h]; lg2[0] = -log1pf(expf(-df)) * 1.4426950408889634f; lg2[1] = -log1pf(expf(-db)) * 1.4426950408889634f; gC[0] = exp2f(lg2[0] * 128.f); gC[1] = exp2f(lg2[1] * 128.f); }
    float vw[2][2];
#pragma unroll
    for (int i = 0; i < 2; ++i) { const int row = (tid >> 3) + 64 * i; vw[0][i] = exp2f(lg2[0] * (float)(127 - row)); vw[1][i] = exp2f(lg2[1] * (float)row); }
    f32x16 S[2];
#pragma unroll
    for (int d = 0; d < 2; ++d)
#pragma unroll
        for (int r = 0; r < 16; ++r) S[d][r] = 0.f;
    u32x4 kst[2][4], vst[2][2];
    auto rowbase = [&](int n, int dir) -> int {
        if (n < 2) return ML + b * CTX + (dir == 0 ? n : 1 - n) * 128;
        return b * SEQ + (dir == 0 ? n - 2 : 33 - n) * 128;
    };
#define SC_ISSUE(n_) do { _Pragma("unroll") for (int dir = 0; dir < 2; ++dir) { const int rb0 = rowbase((n_), dir); \
        _Pragma("unroll") for (int i = 0; i < 4; ++i) { const int id = tid + 512 * i; kst[dir][i] = *(const u32x4*)(RK + (size_t)(rb0 + (id >> 4)) * 512 + h * 128 + (id & 15) * 8); } \
        _Pragma("unroll") for (int i = 0; i < 2; ++i) { const int id = tid + 512 * i; vst[dir][i] = *(const u32x4*)(RV + (size_t)(rb0 + (id >> 3)) * 1024 + h * 256 + dvs * 64 + (id & 7) * 8); } } } while (0)
    SC_ISSUE(0);
    unsigned rmw[16];
#pragma unroll
    for (int r = 0; r < 16; ++r) rmw[r] = 0u;
    const size_t oc_lane = (size_t)(b * SEQ + 32 * rb + 4 * hh) * 1024 + h * 256 + dvs * 64 + 32 * vb + l31;
    for (int n = 0; n < 34; ++n) {
        const bool lat = n >= 2, second = n >= 18;
        bf16x8 qf[8];
        if (lat) { const bf16* q = RQ + (size_t)(rowbase(n, 0) + 32 * rb + l31) * 512 + h * 128 + 8 * hh;
#pragma unroll
            for (int s = 0; s < 8; ++s) qf[s] = *(const bf16x8*)(q + 16 * s); }
#pragma unroll
        for (int dir = 0; dir < 2; ++dir) {
#pragma unroll
            for (int i = 0; i < 4; ++i) { const int id = tid + 512 * i; *(LAS u32x4*)(lds + SC_K + dir * 128 * SC_KP + (id >> 4) * SC_KP + (id & 15) * 16) = kst[dir][i]; }
#pragma unroll
            for (int i = 0; i < 2; ++i) { const int id = tid + 512 * i; float t[8]; unpack8(vst[dir][i], t);
#pragma unroll
                for (int j = 0; j < 8; ++j) t[j] *= vw[dir][i];
                *(LAS u32x4*)(lds + SC_V + dir * 128 * SC_VP + (id >> 3) * SC_VP + (id & 7) * 16) = pack8(t); }
#pragma unroll
            for (int g = 0; g < 4; ++g) { u32x2 wv; wv.x = cvtpk(S[dir][4 * g], S[dir][4 * g + 1]); wv.y = cvtpk(S[dir][4 * g + 2], S[dir][4 * g + 3]);
                *(LAS u32x2*)(lds + SC_ST + dir * 64 * SC_KP + (32 * vb + l31) * SC_KP + (32 * rb + 8 * g + 4 * hh) * 2) = wv; }
        }
        __syncthreads();
#pragma unroll
        for (int dir = 0; dir < 2; ++dir) {
            if (lat) {
                f32x16 o;
#pragma unroll
                for (int r = 0; r < 16; ++r) o[r] = 0.f;
#pragma unroll
                for (int s = 0; s < 8; ++s) { const bf16x8 bfr = *(const LAS bf16x8*)(lds + SC_ST + dir * 64 * SC_KP + (32 * vb + l31) * SC_KP + (16 * s + 8 * hh) * 2); o = MFMA32(qf[s], bfr, o); }
                const int c = (dir == 0) ? n - 2 : 33 - n;
                bf16* dst = OC + oc_lane + (size_t)c * 128 * 1024;
                const float e0 = (dir == 0) ? (float)(32 * rb + 4 * hh + 1) : (float)(128 - 32 * rb - 4 * hh);
#pragma unroll
                for (int r = 0; r < 16; ++r) { const int io = (r & 3) + 8 * (r >> 2);
                    const float sc = fexp2(lg2[dir] * (dir == 0 ? e0 + (float)io : e0 - (float)io));
                    float val = o[r] * sc;
                    if (second) val += bf2f((bf16)rmw[r]);
                    dst[(size_t)io * 1024] = f2bf(val); }
                if (dir == 0) {
                    const bf16* q = RQ + (size_t)(rowbase(n, 1) + 32 * rb + l31) * 512 + h * 128 + 8 * hh;
#pragma unroll
                    for (int s = 0; s < 8; ++s) qf[s] = *(const bf16x8*)(q + 16 * s);
                    if (second) { const bf16* src1 = OC + oc_lane + (size_t)(33 - n) * 128 * 1024;
#pragma unroll
                        for (int r = 0; r < 16; ++r) rmw[r] = src1[(size_t)((r & 3) + 8 * (r >> 2)) * 1024]; }
                }
            }
            if (dir == 0 && n + 1 < 34) SC_ISSUE(n + 1);
#pragma unroll
            for (int r = 0; r < 16; ++r) S[dir][r] *= gC[dir];
            const int q4 = (lane & 15) >> 2, p4 = lane & 3, blk = (lane >> 4) & 1;
            const unsigned ka = ldsb + SC_K + dir * 128 * SC_KP + (8 * hh + q4) * SC_KP + (32 * rb + 16 * blk) * 2 + 8 * p4;
            const unsigned va = ldsb + SC_V + dir * 128 * SC_VP + (8 * hh + q4) * SC_VP + (32 * vb + 16 * blk) * 2 + 8 * p4;
#pragma unroll
            for (int s = 0; s < 8; ++s) {
                const bf16x8 af = cat4(trr(ka + (16 * s) * SC_KP), trr(ka + (16 * s + 4) * SC_KP));
                const bf16x8 bfr = cat4(trr(va + (16 * s) * SC_VP), trr(va + (16 * s + 4) * SC_VP));
                S[dir] = MFMA32(af, bfr, S[dir]);
            }
        }
        if (n + 1 >= 18 && n + 1 < 34) { const bf16* src0 = OC + oc_lane + (size_t)(n - 1) * 128 * 1024;
#pragma unroll
            for (int r = 0; r < 16; ++r) rmw[r] = src0[(size_t)((r & 3) + 8 * (r >> 2)) * 1024]; }
        __syncthreads();
    }
#undef SC_ISSUE
}

constexpr int RO_VP = 528, RO_STAT = 128 * RO_VP;
DI void retout_item(const Params& p, LAS unsigned char* lds, int item) {
    int tid_ = threadIdx.x; asm volatile("" : "+v"(tid_));
    const int tid = tid_, lane = tid & 63, w = tid >> 6, iblk = w & 3, dvh = w >> 2, l31 = lane & 31, hh = lane >> 5;
    const int b = item >> 7, h = (item >> 5) & 3, c = item & 31;
    const bf16* RQ = (const bf16*)(p.ws + O_RQ); const bf16* RK = (const bf16*)(p.ws + O_RK); const bf16* RV = (const bf16*)(p.ws + O_RV);
    const bf16* OC = (const bf16*)(p.ws + O_OC); bf16* RG = (bf16*)(p.ws + O_RG);
    const unsigned ldsb = (unsigned)(size_t)lds;
    const int row0 = b * SEQ + c * 128;
    const float lgf = -log1pf(expf(-p.dec_f[h])) * 1.4426950408889634f, lgb = -log1pf(expf(-p.dec_b[h])) * 1.4426950408889634f;
#pragma unroll
    for (int i = 0; i < 8; ++i) { const int id = tid + 512 * i; const u32x4 v = *(const u32x4*)(RV + (size_t)(row0 + (id >> 5)) * 1024 + h * 256 + (id & 31) * 8);
        *(LAS u32x4*)(lds + (id >> 5) * RO_VP + (id & 31) * 16) = v; }
    bf16x8 qf[8];
    { const bf16* q = RQ + (size_t)(row0 + 32 * iblk + l31) * 512 + h * 128 + 8 * hh;
#pragma unroll
        for (int s = 0; s < 8; ++s) qf[s] = *(const bf16x8*)(q + 16 * s); }
    bf16x8 pf[4][2];
    const int icol = 32 * iblk + l31;
#pragma unroll
    for (int jb = 0; jb < 4; ++jb) {
        f32x16 x;
#pragma unroll
        for (int r = 0; r < 16; ++r) x[r] = 0.f;
        const bf16* kp = RK + (size_t)(row0 + 32 * jb + l31) * 512 + h * 128 + 8 * hh;
#pragma unroll
        for (int s = 0; s < 8; ++s) { const bf16x8 kf = *(const bf16x8*)(kp + 16 * s); x = MFMA32(kf, qf[s], x); }
        if (jb < iblk) {
#pragma unroll
            for (int r = 0; r < 16; ++r) { const int df = icol - (32 * jb + crow(r, hh)); x[r] *= fexp2(lgf * (float)df); }
        } else if (jb > iblk) {
#pragma unroll
            for (int r = 0; r < 16; ++r) { const int df = icol - (32 * jb + crow(r, hh)); x[r] *= fexp2(-lgb * (float)df); }
        } else {
#pragma unroll
            for (int r = 0; r < 16; ++r) { const int df = icol - (32 * jb + crow(r, hh)); const float fd = (float)df;
                const float e = fexp2(fminf(lgf * fd, -lgb * fd)); x[r] *= (df == 0) ? 2.f : e; }
        }
        pf[jb][0] = packstep(x, 0); pf[jb][1] = packstep(x, 1);
    }
    __syncthreads();
    f32x16 ot[4];
    {
        const int q4 = (lane & 15) >> 2, p4 = lane & 3, blk = (lane >> 4) & 1;
#pragma unroll
        for (int dt = 0; dt < 4; ++dt) {
#pragma unroll
            for (int r = 0; r < 16; ++r) ot[dt][r] = 0.f;
            const unsigned va = ldsb + (4 * hh + q4) * RO_VP + (128 * dvh + 32 * dt + 16 * blk) * 2 + 8 * p4;
#pragma unroll
            for (int jb = 0; jb < 4; ++jb)
#pragma unroll
                for (int s = 0; s < 2; ++s) {
                    const bf16x8 af = cat4(trr(va + (32 * jb + 16 * s) * RO_VP), trr(va + (32 * jb + 16 * s + 8) * RO_VP));
                    ot[dt] = MFMA32(af, pf[jb][s], ot[dt]);
                }
        }
    }
    const size_t grow = (size_t)(row0 + icol) * 1024 + h * 256 + 128 * dvh;
    float s1 = 0.f, s2 = 0.f;
#pragma unroll
    for (int dt = 0; dt < 4; ++dt)
#pragma unroll
        for (int g = 0; g < 4; ++g) { const u32x2 ocv = *(const u32x2*)(OC + grow + 32 * dt + 8 * g + 4 * hh);
            ot[dt][4 * g] += bflo(ocv.x); ot[dt][4 * g + 1] += bfhi(ocv.x); ot[dt][4 * g + 2] += bflo(ocv.y); ot[dt][4 * g + 3] += bfhi(ocv.y);
#pragma unroll
            for (int e = 0; e < 4; ++e) { const float t = ot[dt][4 * g + e]; s1 += t; s2 += t * t; } }
    s1 += __shfl_xor(s1, 32); s2 += __shfl_xor(s2, 32);
    LAS float* st = (LAS float*)(lds + RO_STAT);
    if (hh == 0) { st[(dvh * 128 + icol) * 2] = s1; st[(dvh * 128 + icol) * 2 + 1] = s2; }
    __syncthreads();
    const float t1 = st[icol * 2] + st[(128 + icol) * 2], t2 = st[icol * 2 + 1] + st[(128 + icol) * 2 + 1];
    const float mean = t1 * (1.f / 256.f); const float var = fmaxf(t2 * (1.f / 256.f) - mean * mean, 0.f); const float rstd = rsqrtf(var + LN_EPS);
#pragma unroll
    for (int dt = 0; dt < 4; ++dt)
#pragma unroll
        for (int g = 0; g < 4; ++g) { bf16* gp = RG + grow + 32 * dt + 8 * g + 4 * hh; const u32x2 gv = *(const u32x2*)gp;
            u32x2 o; o.x = cvtpk((ot[dt][4 * g] - mean) * rstd * bflo(gv.x), (ot[dt][4 * g + 1] - mean) * rstd * bfhi(gv.x));
            o.y = cvtpk((ot[dt][4 * g + 2] - mean) * rstd * bflo(gv.y), (ot[dt][4 * g + 3] - mean) * rstd * bfhi(gv.y));
            *(u32x2*)gp = o; }
    __syncthreads();
}

constexpr int AT_KP = 208, AT_VP = 144, AT_V = 64 * AT_KP, AT_BUF = AT_V + 64 * AT_VP;
DI void attn_unit(const Params& p, LAS unsigned char* lds, int unit) {
    int tid_ = threadIdx.x; asm volatile("" : "+v"(tid_));
    const int tid = tid_, lane = tid & 63, w = tid >> 6, l31 = lane & 31, hh = lane >> 5;
    const int bh = unit >> 4, qb = unit & 15, b = bh >> 3, h = bh & 7;
    const bf16* QM = (const bf16*)((unsigned char*)p.out + OO_QM); const bf16* KN = (const bf16*)((unsigned char*)p.out + OO_KN); const bf16* VN = (const bf16*)((unsigned char*)p.out + OO_VN); const bf16* KR = (const bf16*)(p.ws + O_KR);
    bf16* AO = (bf16*)(p.ws + O_AO);
    const unsigned ldsb = (unsigned)(size_t)lds;
    bf16x8 qf[6];
    { const bf16* q = QM + ((size_t)bh * SEQ + qb * 256 + 32 * w + l31) * 96 + 8 * hh;
#pragma unroll
        for (int s = 0; s < 6; ++s) qf[s] = *(const bf16x8*)(q + 16 * s); }
    const bf16* kn = KN + (size_t)bh * KEYS * 64 + (size_t)(tid >> 3) * 64 + (tid & 7) * 8;
    const bf16* vn = VN + (size_t)bh * KEYS * 64 + (size_t)(tid >> 3) * 64 + (tid & 7) * 8;
    const bf16* kr = KR + (size_t)b * KEYS * 32 + (size_t)((tid & 255) >> 2) * 32 + (tid & 3) * 8;
    u32x4 sk, sv, sr;
#define AT_ISSUE(t_) do { sk = *(const u32x4*)(kn + (size_t)(t_) * 64 * 64); sv = *(const u32x4*)(vn + (size_t)(t_) * 64 * 64); if (tid < 256) sr = *(const u32x4*)(kr + (size_t)(t_) * 64 * 32); } while (0)
#define AT_WRITE(buf_) do { LAS unsigned char* bb_ = lds + (buf_) * AT_BUF; *(LAS u32x4*)(bb_ + (tid >> 3) * AT_KP + (tid & 7) * 16) = sk; *(LAS u32x4*)(bb_ + AT_V + (tid >> 3) * AT_VP + (tid & 7) * 16) = sv; \
        if (tid < 256) *(LAS u32x4*)(bb_ + (tid >> 2) * AT_KP + 128 + (tid & 3) * 16) = sr; } while (0)
    f32x16 o[2];
#pragma unroll
    for (int d = 0; d < 2; ++d)
#pragma unroll
        for (int r = 0; r < 16; ++r) o[d][r] = 0.f;
    float m = -1e30f, lsum = 0.f;
    AT_ISSUE(0); AT_WRITE(0); AT_ISSUE(1);
    __syncthreads();
    constexpr int NT = KEYS / 64;
    const int q4 = (lane & 15) >> 2, p4 = lane & 3, blk = (lane >> 4) & 1;
    for (int t = 0; t < NT; ++t) {
        const unsigned kb0 = ldsb + (t & 1) * AT_BUF;
        f32x16 x[2];
#pragma unroll
        for (int kb = 0; kb < 2; ++kb) {
#pragma unroll
            for (int r = 0; r < 16; ++r) x[kb][r] = 0.f;
#pragma unroll
            for (int s = 0; s < 6; ++s) { const bf16x8 kf = *(const LAS bf16x8*)(lds + (t & 1) * AT_BUF + (32 * kb + l31) * AT_KP + (16 * s + 8 * hh) * 2); x[kb] = MFMA32(kf, qf[s], x[kb]); }
        }
        float mx = x[0][0];
#pragma unroll
        for (int r = 1; r < 16; ++r) mx = fmaxf(mx, x[0][r]);
#pragma unroll
        for (int r = 0; r < 16; ++r) mx = fmaxf(mx, x[1][r]);
        mx = fmaxf(mx, __shfl_xor(mx, 32));
        const float mn = fmaxf(m, mx), alpha = fexp2(m - mn);
        m = mn;
        float ps = 0.f;
#pragma unroll
        for (int kb = 0; kb < 2; ++kb)
#pragma unroll
            for (int r = 0; r < 16; ++r) { const float e = fexp2(x[kb][r] - mn); x[kb][r] = e; ps += e; }
        lsum = lsum * alpha + ps;
#pragma unroll
        for (int d = 0; d < 2; ++d)
#pragma unroll
            for (int r = 0; r < 16; ++r) o[d][r] *= alpha;
        bf16x8 pf[2][2];
#pragma unroll
        for (int kb = 0; kb < 2; ++kb) { pf[kb][0] = packstep(x[kb], 0); pf[kb][1] = packstep(x[kb], 1); }
#pragma unroll
        for (int dt = 0; dt < 2; ++dt) {
            const unsigned va = kb0 + AT_V + (4 * hh + q4) * AT_VP + (32 * dt + 16 * blk) * 2 + 8 * p4;
#pragma unroll
            for (int kb = 0; kb < 2; ++kb)
#pragma unroll
                for (int s = 0; s < 2; ++s) {
                    const bf16x8 af = cat4(trr(va + (32 * kb + 16 * s) * AT_VP), trr(va + (32 * kb + 16 * s + 8) * AT_VP));
                    o[dt] = MFMA32(af, pf[kb][s], o[dt]);
                }
        }
        if (t + 1 < NT) { AT_WRITE((t + 1) & 1); if (t + 2 < NT) AT_ISSUE(t + 2); }
        __syncthreads();
    }
    const float l = lsum + __shfl_xor(lsum, 32), inv = 1.f / l;
    bf16* dst = AO + (size_t)(b * SEQ + qb * 256 + 32 * w + l31) * 512 + h * 64;
#pragma unroll
    for (int dt = 0; dt < 2; ++dt)
#pragma unroll
        for (int g = 0; g < 4; ++g) { u32x2 wv; wv.x = cvtpk(o[dt][4 * g] * inv, o[dt][4 * g + 1] * inv); wv.y = cvtpk(o[dt][4 * g + 2] * inv, o[dt][4 * g + 3] * inv);
            *(u32x2*)(dst + 32 * dt + 8 * g + 4 * hh) = wv; }
#undef AT_ISSUE
#undef AT_WRITE
}

template <class F> DI void run_gemm(LAS unsigned char* lds, const bf16* A, const bf16* Bt, int M, int N, int K, int G, int c, const F& f, int pn_off = 0) {
    pg8::Gemm g{A, Bt, M, N, K}; pg8::StaticOrder S; S.init(M, N, G, c);
    EpiG<F> E{f, pn_off};
    pg8::gemm_phase<EpiG<F>, pg8::StaticOrder, true, true>(lds, g, S, E);
}

typedef const __attribute__((address_space(4))) Params* KP;
#define PH_BEGIN int G = gridDim.x, bx = blockIdx.x; asm volatile("" : "+s"(G), "+s"(bx)); (void)G; (void)bx; KP q_ = kp; asm volatile("" : "+s"(q_)); const Params p = *q_; unsigned char* ws = p.ws; unsigned char* ob = (unsigned char*)p.out; const float* mod = (const float*)(ws + O_MOD); float* SS = (float*)(ws + O_SS); (void)ob; (void)mod; (void)SS;
#ifndef PH_MASK
#define PH_MASK 0xFFFFFF
#endif
#ifndef REP_MASK
#define REP_MASK 0
#endif
#define NREP(bit) ((REP_MASK & (bit)) ? 2 : 1)
__global__ void __launch_bounds__(512, 2) fwd_kernel(Params p_unused) {
#if defined(__HIP_DEVICE_COMPILE__)
    extern __shared__ __attribute__((aligned(16))) unsigned char lds_raw[];
    LAS unsigned char* lds = (LAS unsigned char*)lds_raw;
    KP kp = (KP)__builtin_amdgcn_kernarg_segment_ptr();

    if (PH_MASK & 1) for (int rep = 0; rep < NREP(1); ++rep) { PH_BEGIN phase0(p, lds); }
    cg::this_grid().sync();
    if (PH_MASK & 2) { PH_BEGIN phase1(p); }
    cg::this_grid().sync();
    if (PH_MASK & 4) {
        PH_BEGIN
        FIn f{(bf16*)(ws + O_RQ), (bf16*)(ws + O_RK), (bf16*)(ws + O_RV), (bf16*)(ws + O_RG), (bf16*)(ws + O_GR), (bf16*)(ws + O_GM), (bf16*)(ws + O_DQ), (bf16*)(ws + O_DKV), (bf16*)(ws + O_KR), SS,
              (const float*)(ws + O_T1), (const float*)(ws + O_T2)};
        run_gemm(lds, (const bf16*)ob, (const bf16*)(ws + O_WINM), MT, 2816, 1024, G, bx, f);
    }
    cg::this_grid().sync();
    {
        int bq = blockIdx.x; asm volatile("" : "+s"(bq));
        if ((PH_MASK & 8) && bq >= 64) {
            PH_BEGIN
            FIn f{(bf16*)(ws + O_RQ), (bf16*)(ws + O_RK), (bf16*)(ws + O_RV), (bf16*)(ws + O_RG), (bf16*)(ws + O_GR), (bf16*)(ws + O_GM), (bf16*)(ws + O_DQ), (bf16*)(ws + O_DKV), (bf16*)(ws + O_KR), SS,
                  (const float*)(ws + O_T1), (const float*)(ws + O_T2)};
            run_gemm(lds, (const bf16*)ob, (const bf16*)(ws + O_WING), ML, 3072, 1024, G - 64, bx - 64, f, 11);
        } else if ((PH_MASK & 16) && bq < 64) {
            for (int rep = 0; rep < NREP(16); ++rep) { PH_BEGIN scan_item(p, lds, bx); }
        }
    }
    cg::this_grid().sync();
    if (PH_MASK & 8) {
        { PH_BEGIN FQ fq{(bf16*)(ob + OO_QM), SS, (const float*)(ws + O_T2)};
          run_gemm(lds, (const bf16*)(ws + O_DQ), (const bf16*)(ws + O_WUQ), ML, 768, 384, G, bx, fq); }
        { PH_BEGIN FKV fkv{(bf16*)(ob + OO_KN), (bf16*)(ob + OO_VN), SS};
          run_gemm(lds, (const bf16*)(ws + O_DKV), (const bf16*)(ws + O_WUKV), MT, 1024, 256, G, bx, fkv); }
    }
    cg::this_grid().sync();
    {
        if (PH_MASK & 32) { PH_BEGIN for (int it = bx; it < 512; it += G) retout_item(p, lds, it); }
        if (PH_MASK & 64) for (int rep = 0; rep < NREP(64); ++rep) { PH_BEGIN for (int u = bx; u < 512; u += G) attn_unit(p, lds, u); }
    }
    cg::this_grid().sync();
    if (PH_MASK & 128) {
        { PH_BEGIN F5a fa{p.out, (const bf16*)(ws + O_GR)};
          run_gemm(lds, (const bf16*)(ws + O_RG), (const bf16*)(ws + O_WRO), ML, 1024, 1024, G, bx, fa); }
        { PH_BEGIN F5b fb{p.out, (const bf16*)(ws + O_GM), (bf16*)(ws + O_GMX)};
          run_gemm(lds, (const bf16*)(ws + O_AO), (const bf16*)(ws + O_WMO), ML, 1024, 512, G, bx, fb); }
    }
    cg::this_grid().sync();
    if (PH_MASK & 256) {
        PH_BEGIN FRes f{p.x, mod + 2048, p.out};
        run_gemm(lds, (const bf16*)(ws + O_GMX), (const bf16*)(ws + O_WOUT), ML, 1024, 1024, G, bx, f);
    }
    cg::this_grid().sync();
    if (PH_MASK & 512) { PH_BEGIN ln_pass(p.out, (float*)(ws + O_X1), p.ln1_g, p.ln1_b, (bf16*)(ws + O_H2), mod); }
    cg::this_grid().sync();
    if (PH_MASK & 1024) {
        PH_BEGIN FGU f{(bf16*)(ws + O_H)};
        run_gemm(lds, (const bf16*)(ws + O_H2), (const bf16*)(ws + O_WGU), ML, NGU, 1024, G, bx, f);
    }
    cg::this_grid().sync();
    if (PH_MASK & 2048) {
        PH_BEGIN FRes f{(const float*)(ws + O_X1), mod + 5120, p.out};
        run_gemm(lds, (const bf16*)(ws + O_H), (const bf16*)(ws + O_WDN), ML, 1024, DFF, G, bx, f);
    }
    cg::this_grid().sync();
    if (PH_MASK & 4096) { PH_BEGIN ln_pass(p.out, p.out, p.ln2_g, p.ln2_b, nullptr, mod); }
#endif
}

extern "C" void kernel_launch(void* const* d_in, const int* in_sizes, int n_in, void* d_out, int out_size, void* d_ws, size_t ws_size, hipStream_t stream) {
    static int grid = 0;
    if (grid == 0) {
        if (n_in != 22 || out_size != ML * DM || ws_size < WS_NEED) { fprintf(stderr, "kernel_launch: unexpected shapes (n_in %d out %d ws %zu)\n", n_in, out_size, ws_size); grid = -1; return; }
        int dev = 0, cus = 0, per_cu = 0;
        (void)hipGetDevice(&dev); (void)hipDeviceGetAttribute(&cus, hipDeviceAttributeMultiprocessorCount, dev);
        if (hipFuncSetAttribute((const void*)fwd_kernel, hipFuncAttributeMaxDynamicSharedMemorySize, LDS_BYTES) != hipSuccess) { fprintf(stderr, "kernel_launch: hipFuncSetAttribute failed\n"); grid = -1; return; }
        if (hipOccupancyMaxActiveBlocksPerMultiprocessor(&per_cu, (const void*)fwd_kernel, 512, LDS_BYTES) != hipSuccess || per_cu < 1) { fprintf(stderr, "kernel_launch: occupancy query says %d\n", per_cu); per_cu = 1; }
        (void)hipGetLastError();
        grid = cus;
    }
    if (grid < 0) return;
    Params p{};
    const float** pp = (const float**)&p;
    for (int i = 0; i < 22; ++i) pp[i] = (const float*)d_in[i];
    p.out = (float*)d_out; p.ws = (unsigned char*)d_ws;
    void* args[] = {&p};
    hipError_t e = hipLaunchCooperativeKernel((const void*)fwd_kernel, dim3(grid), dim3(512), args, LDS_BYTES, stream);
    if (e != hipSuccess) fprintf(stderr, "cooperative launch failed: %s (grid %d)\n", hipGetErrorString(e), grid);
}
```

```cpp
#include <hip/hip_runtime.h>
#include <hip/hip_cooperative_groups.h>
#include <cstdio>
#include <cstdint>
namespace cg = cooperative_groups;
#define REP_MASK 0
namespace pg8 {
#define PG8_LAS __attribute__((address_space(3)))
typedef unsigned short bf16_t;
typedef short bf16x8 __attribute__((ext_vector_type(8)));
typedef float f32x4 __attribute__((ext_vector_type(4)));
typedef unsigned u32x4 __attribute__((ext_vector_type(4)));
constexpr int BM = 256, BK = 64, HALF = 128, HTB = HALF * BK * 2  , STAGE_BYTES = 8 * HTB, NXCD = 8, WGM = 8;

__host__ __device__ __forceinline__ int lds_byte(int r, int c) { const int st = (r >> 4) * 2 + (c >> 5), rr = r & 15, cc = c & 31, ob = rr * 64 + cc * 2; return st * 1024 + (ob ^ (((ob >> 9) & 1) << 5)); }
__host__ __device__ __forceinline__ void stage_rc(int b, int& R, int& C) { const int st = b / 1024, sb = b % 1024, swz = sb ^ (((sb >> 9) & 1) << 5); R = (st >> 1) * 16 + swz / 64; C = (st & 1) * 32 + (swz % 64) / 2; }
__host__ __device__ __forceinline__ int perm32(int rho) { const int n = rho >> 4, i = rho & 15; return 8 * (i >> 2) + 4 * n + (i & 3); }

struct Unit { int pm, pn; };
struct Gemm { const bf16_t* A; const bf16_t* Bt; int M, N, K; };

struct StaticOrder {
    int nM, nN, nwg, G, c;
    __host__ __device__ void init(int M, int N, int G_, int c_) { nM = M / BM; nN = N / BM; nwg = nM * nN; G = G_; c = c_; }
    __host__ __device__ bool next(int i, Unit& u) const {
        const long L = (long)i * G + c; if (L >= nwg) return false;
        int wgid = (int)L; { const int q = nwg / NXCD, r = nwg % NXCD, xcd = wgid % NXCD, off = wgid / NXCD; wgid = (xcd < r ? xcd * (q + 1) : r * (q + 1) + (xcd - r) * q) + off; }
        const int nig = WGM * nN, gid = wgid / nig, fm = gid * WGM, gsz = (nM - fm) < WGM ? (nM - fm) : WGM;
        u.pm = fm + ((wgid % nig) % gsz); u.pn = (wgid % nig) / gsz; return true;
    }
    __device__ __forceinline__ void a_ready(const Unit&) const {}
    __device__ __forceinline__ void done(const Unit&) const {}
};

__device__ __forceinline__ unsigned cvt_pk_bf16(float lo, float hi) { unsigned r; asm volatile("v_cvt_pk_bf16_f32 %0, %1, %2" : "=v"(r) : "v"(lo), "v"(hi)); return r; }
typedef float f32x2 __attribute__((ext_vector_type(2)));
template <class Epi, class Sched, bool ALIGN_EPI = false, bool SP2 = false>
__device__ __forceinline__ void gemm_phase(PG8_LAS unsigned char* lds, const Gemm g, const Sched& S, const Epi& E) {
    int tid_l = threadIdx.x; asm volatile("" : "+v"(tid_l));
    const int tid = tid_l, wid = __builtin_amdgcn_readfirstlane(tid >> 6), lane = tid & 63, wr = wid >> 2, wc = wid & 3, fr = lane & 15, fq = lane >> 4;
    const int K = g.K, nt = K / BK;
    unsigned voffA[2], voffB[2];
#pragma unroll
    for (int i = 0; i < 2; ++i) { int R, C; stage_rc(tid * 16 + i * 8192, R, C); const int Rb = Epi::PERM ? ((R & ~31) + perm32(R & 31)) : R;
        voffA[i] = (unsigned)(R * K + C) * 2u; voffB[i] = (unsigned)(Rb * K + C) * 2u; }
    const size_t kstep = (size_t)(BK * 2);
    const size_t hstep = (size_t)HALF * K * 2;
    const size_t tstep = 2 * hstep;
    const unsigned ldsw = (unsigned)wid * 1024u;
    const int aoff = lds_byte(wr * 64 + fr, fq * 8), boff = lds_byte(wc * 32 + fr, fq * 8);
#define PG8_SA(b, h) (((b) * 2 + (h)) * HTB)
#define PG8_SB(b, h) ((4 + (b) * 2 + (h)) * HTB)
#define PG8_STAGE(bufoff, gbase, voff) do { _Pragma("unroll") for (int _i = 0; _i < 2; ++_i) \
        __builtin_amdgcn_global_load_lds((const unsigned*)((const char*)(gbase) + (voff)[_i]), (PG8_LAS unsigned*)(lds + (bufoff) + ldsw + _i * 8192), 16, 0, 0); } while (0)
#define PG8_LDA(dst, b, h) do { _Pragma("unroll") for (int m = 0; m < 4; ++m) _Pragma("unroll") for (int k = 0; k < 2; ++k) dst[m][k] = *(const PG8_LAS bf16x8*)(lds + PG8_SA(b, h) + aoff + m * 2048 + k * 1024); } while (0)
#define PG8_LDB(dst, b, h) do { _Pragma("unroll") for (int n = 0; n < 2; ++n) _Pragma("unroll") for (int k = 0; k < 2; ++k) dst[n][k] = *(const PG8_LAS bf16x8*)(lds + PG8_SB(b, h) + boff + n * 2048 + k * 1024); } while (0)
#define PG8_MMA(ai, bj, At, Bt) do { __builtin_amdgcn_s_setprio(1); _Pragma("unroll") for (int m = 0; m < 4; ++m) _Pragma("unroll") for (int n = 0; n < 2; ++n) _Pragma("unroll") for (int k = 0; k < 2; ++k) \
        acc[ai][bj][m][n] = __builtin_amdgcn_mfma_f32_16x16x32_bf16(Bt[n][k], At[m][k], acc[ai][bj][m][n], 0, 0, 0); __builtin_amdgcn_s_setprio(0); } while (0)
#define PG8_WAIT_V(n) asm volatile("s_waitcnt vmcnt(" #n ")" ::: "memory")
#define PG8_WAIT_L(n) asm volatile("s_waitcnt lgkmcnt(" #n ")" ::: "memory")
#define PG8_BAR __builtin_amdgcn_s_barrier()
#define PG8_SCHED __builtin_amdgcn_sched_barrier(0)
    Unit cur, nxt; int ui = 0;
    if (!S.next(0, cur)) return;
    f32x4 acc[2][2][4][2];
#pragma unroll
    for (int a = 0; a < 2; ++a)
#pragma unroll
        for (int b = 0; b < 2; ++b)
#pragma unroll
            for (int m = 0; m < 4; ++m)
#pragma unroll
                for (int n = 0; n < 2; ++n) acc[a][b][m][n] = (f32x4){0.f, 0.f, 0.f, 0.f};
    bf16x8 At[4][2], B0[2][2], B1[2][2];
    const char* cA = (const char*)g.A + (size_t)cur.pm * tstep; const char* cB = (const char*)g.Bt + (size_t)cur.pn * tstep;
    S.a_ready(cur);
    if constexpr (SP2) {
        PG8_STAGE(PG8_SB(0, 0), cB, voffB); PG8_STAGE(PG8_SB(0, 1), cB + hstep, voffB); PG8_STAGE(PG8_SA(0, 0), cA, voffA); PG8_STAGE(PG8_SA(0, 1), cA + hstep, voffA);
        if (wr == 1) PG8_BAR;
        PG8_WAIT_V(2); PG8_BAR;
        PG8_STAGE(PG8_SB(1, 0), cB + kstep, voffB); PG8_STAGE(PG8_SA(1, 0), cA + kstep, voffA); PG8_STAGE(PG8_SB(1, 1), cB + hstep + kstep, voffB);
        PG8_WAIT_V(6); PG8_BAR;
    } else {
        PG8_STAGE(PG8_SB(0, 0), cB, voffB); PG8_STAGE(PG8_SA(0, 0), cA, voffA); PG8_STAGE(PG8_SB(0, 1), cB + hstep, voffB); PG8_STAGE(PG8_SA(0, 1), cA + hstep, voffA);
        if (wr == 1) PG8_BAR;
        PG8_WAIT_V(4); PG8_BAR;
        PG8_STAGE(PG8_SB(1, 0), cB + kstep, voffB); PG8_STAGE(PG8_SA(1, 0), cA + kstep, voffA); PG8_STAGE(PG8_SB(1, 1), cB + hstep + kstep, voffB);
        PG8_WAIT_V(6); PG8_BAR;
    }
    for (;;) {
        const bool has_next = S.next(ui + 1, nxt);
        const char* nA = has_next ? (const char*)g.A + (size_t)nxt.pm * tstep : cA; const char* nB = has_next ? (const char*)g.Bt + (size_t)nxt.pn * tstep : cB;
        for (int t = 0; t < nt; t += 2) {
            const bool last = (t == nt - 2);
            const char* a1 = cA + (size_t)(t + 1) * kstep;
            const char* a2 = last ? nA : cA + (size_t)(t + 2) * kstep; const char* b2 = last ? nB : cB + (size_t)(t + 2) * kstep;
            const char* a3 = a2 + kstep; const char* b3 = b2 + kstep;
            if (last && has_next) S.a_ready(nxt);
            if constexpr (SP2) {
            PG8_LDB(B0, 0, 0); PG8_LDB(B1, 0, 1); PG8_SCHED; PG8_LDA(At, 0, 0); PG8_STAGE(PG8_SA(1, 1), a1 + hstep, voffA);
            PG8_WAIT_V(8); PG8_WAIT_L(0); PG8_BAR; PG8_MMA(0, 0, At, B0); PG8_MMA(0, 1, At, B1); PG8_BAR; PG8_SCHED;
            PG8_LDA(At, 0, 1); PG8_STAGE(PG8_SB(0, 0), b2, voffB); PG8_STAGE(PG8_SB(0, 1), b2 + hstep, voffB); PG8_STAGE(PG8_SA(0, 0), a2, voffA);
            PG8_WAIT_V(8); PG8_WAIT_L(0); PG8_BAR; PG8_MMA(1, 0, At, B0); PG8_MMA(1, 1, At, B1); PG8_BAR; PG8_SCHED;
            PG8_LDB(B0, 1, 0); PG8_LDB(B1, 1, 1); PG8_SCHED; PG8_LDA(At, 1, 0); PG8_STAGE(PG8_SA(0, 1), a2 + hstep, voffA);
            PG8_WAIT_V(8); PG8_WAIT_L(0); PG8_BAR; PG8_MMA(0, 0, At, B0); PG8_MMA(0, 1, At, B1); PG8_BAR; PG8_SCHED;
            PG8_LDA(At, 1, 1); PG8_STAGE(PG8_SB(1, 0), b3, voffB); PG8_STAGE(PG8_SB(1, 1), b3 + hstep, voffB); PG8_STAGE(PG8_SA(1, 0), a3, voffA);
            PG8_WAIT_V(8); PG8_WAIT_L(0); PG8_BAR; PG8_MMA(1, 0, At, B0); PG8_MMA(1, 1, At, B1); PG8_BAR; PG8_SCHED;
            } else {
            PG8_LDB(B0, 0, 0); PG8_SCHED; PG8_LDA(At, 0, 0); PG8_STAGE(PG8_SA(1, 1), a1 + hstep, voffA);
            PG8_WAIT_L(8); PG8_BAR; PG8_WAIT_L(0); PG8_MMA(0, 0, At, B0); PG8_BAR; PG8_SCHED;
            PG8_LDB(B1, 0, 1); PG8_STAGE(PG8_SB(0, 0), b2, voffB);
            PG8_BAR; PG8_WAIT_L(0); PG8_MMA(0, 1, At, B1); PG8_BAR;
            PG8_LDA(At, 0, 1); PG8_STAGE(PG8_SA(0, 0), a2, voffA);
            PG8_BAR; PG8_WAIT_L(0); PG8_MMA(1, 0, At, B0); PG8_BAR; PG8_SCHED;
            PG8_STAGE(PG8_SB(0, 1), b2 + hstep, voffB);
            PG8_WAIT_V(6); PG8_BAR; PG8_MMA(1, 1, At, B1); PG8_BAR;
            PG8_LDB(B0, 1, 0); PG8_SCHED; PG8_LDA(At, 1, 0); PG8_STAGE(PG8_SA(0, 1), a2 + hstep, voffA);
            PG8_WAIT_L(8); PG8_BAR; PG8_WAIT_L(0); PG8_MMA(0, 0, At, B0); PG8_BAR; PG8_SCHED;
            PG8_LDB(B1, 1, 1); PG8_STAGE(PG8_SB(1, 0), b3, voffB);
            PG8_BAR; PG8_WAIT_L(0); PG8_MMA(0, 1, At, B1); PG8_BAR;
            PG8_LDA(At, 1, 1); PG8_STAGE(PG8_SA(1, 0), a3, voffA);
            PG8_BAR; PG8_WAIT_L(0); PG8_MMA(1, 0, At, B0); PG8_BAR; PG8_SCHED;
            PG8_STAGE(PG8_SB(1, 1), b3 + hstep, voffB);
            PG8_WAIT_V(6); PG8_BAR; PG8_MMA(1, 1, At, B1); PG8_BAR;
            }
        }
        if constexpr (ALIGN_EPI) { if (wr == 0) PG8_BAR; }
        if constexpr (!Epi::AFTER_DRAIN) { E(acc, cur, wr, wc, fr, fq); S.done(cur); }
        if (!has_next) break;
#pragma unroll
        for (int a = 0; a < 2; ++a)
#pragma unroll
            for (int b = 0; b < 2; ++b)
#pragma unroll
                for (int m = 0; m < 4; ++m)
#pragma unroll
                    for (int n = 0; n < 2; ++n) acc[a][b][m][n] = (f32x4){0.f, 0.f, 0.f, 0.f};
        cur = nxt; cA = nA; cB = nB; ++ui;
        if constexpr (ALIGN_EPI) { if (wr == 1) PG8_BAR; }
    }
    PG8_WAIT_V(0);
    if constexpr (!ALIGN_EPI) { if (wr == 0) PG8_BAR; }
    PG8_BAR;
    if constexpr (Epi::AFTER_DRAIN) { E.fused(acc, cur, wr, wc, fr, fq, lds, wid, lane); S.done(cur); }
#undef PG8_SA
#undef PG8_SB
#undef PG8_STAGE
#undef PG8_LDA
#undef PG8_LDB
#undef PG8_MMA
#undef PG8_WAIT_V
#undef PG8_WAIT_L
#undef PG8_BAR
#undef PG8_SCHED
}
}

#define LAS __attribute__((address_space(3)))
#define DI __device__ __forceinline__
typedef unsigned short bf16;
typedef short bf16x8 __attribute__((ext_vector_type(8)));
typedef short s16x4 __attribute__((ext_vector_type(4)));
typedef short v4i16_t __attribute__((ext_vector_type(4)));
typedef float f32x4 __attribute__((ext_vector_type(4)));
typedef float f32x16 __attribute__((ext_vector_type(16)));
typedef unsigned u32x4 __attribute__((ext_vector_type(4)));
typedef unsigned u32x2 __attribute__((ext_vector_type(2)));
typedef float f32x2_t __attribute__((ext_vector_type(2)));
typedef __bf16 bf16x2_t __attribute__((ext_vector_type(2)));
#define MFMA32(a, b, c) __builtin_amdgcn_mfma_f32_32x32x16_bf16((a), (b), (c), 0, 0, 0)

constexpr int DM = 1024, NBAT = 4, SEQ = 4096, CTX = 256, ML = NBAT * SEQ, MC = NBAT * CTX, MT = ML + MC, KEYS = CTX + SEQ;
constexpr int NIN = 5888, INW = 5792, DFF = 2816, NGU = 5632;
constexpr size_t MiB = 1u << 20;
constexpr size_t O_WGU = 0, O_WDN = O_WGU + (size_t)NGU * 1024 * 2, O_WOUT = O_WDN + (size_t)1024 * DFF * 2, O_WRO = O_WOUT + 2 * MiB, O_WMO = O_WRO + 2 * MiB,
                 O_WUQ = O_WMO + 1 * MiB, O_WUKV = O_WUQ + 768 * 384 * 2, O_MOD = O_WUKV + 1024 * 256 * 2, O_T1 = O_MOD + 5 * 6144 * 4, O_T2 = O_T1 + 4096 * 64 * 8,
                 O_SS = O_T2 + 64 * 8 * 8, O_MISC_END = O_SS + (size_t)MT * 24 * 4;
static_assert(O_MISC_END <= 27 * MiB, "misc region");
constexpr size_t O_RQ = 27 * MiB, O_RK = 43 * MiB, O_RV = 60 * MiB, O_RG = 94 * MiB, O_GR = 126 * MiB, O_GM = 158 * MiB, O_DQ = 190 * MiB, O_DKV = 202 * MiB,
                 O_WING = 211 * MiB, O_WINM = 217 * MiB, O_OC = 217 * MiB, O_KR = 254 * MiB, O_AO = 190 * MiB, O_GMX = 27 * MiB, O_X1 = 94 * MiB, O_H2 = 59 * MiB, O_H = 158 * MiB,
                 WS_NEED = 256 * MiB;
constexpr size_t OO_QM = 0, OO_KN = 24 * MiB, OO_VN = 41 * MiB;
constexpr int LDS_BYTES = 147456;
constexpr float ALPHA = 1.189207115002721f;
constexpr float LN_EPS = 1e-5f, RMS_EPS = 1e-6f;
constexpr float QSCALE = 0.10206207261596575f * 1.4426950408889634f;
constexpr float KSCALE = 0.08838834764831845f;

struct Params {
    const float *x, *c, *ctx, *c_ctx, *w_ada, *b_ada, *w_in, *dec_f, *dec_b, *w_ret_o, *q_norm, *w_uq, *kv_norm, *w_ukv, *w_mla_o, *w_out, *ln1_g, *ln1_b, *w_gu, *w_down, *ln2_g, *ln2_b;
    float* out; unsigned char* ws;
};

DI unsigned cvtpk(float lo, float hi) { f32x2_t v = {lo, hi}; bf16x2_t b = __builtin_convertvector(v, bf16x2_t); return __builtin_bit_cast(unsigned, b); }
DI float bflo(unsigned u) { return __uint_as_float(u << 16); }
DI float bfhi(unsigned u) { return __uint_as_float(u & 0xffff0000u); }
DI float bf2f(bf16 v) { return __uint_as_float(((unsigned)v) << 16); }
DI bf16 f2bf(float f) { return (bf16)(cvtpk(f, 0.f) & 0xffffu); }
DI u32x4 pack8(const float (&v)[8]) { u32x4 w; w.x = cvtpk(v[0], v[1]); w.y = cvtpk(v[2], v[3]); w.z = cvtpk(v[4], v[5]); w.w = cvtpk(v[6], v[7]); return w; }
DI void unpack8(u32x4 w, float (&v)[8]) { v[0] = bflo(w.x); v[1] = bfhi(w.x); v[2] = bflo(w.y); v[3] = bfhi(w.y); v[4] = bflo(w.z); v[5] = bfhi(w.z); v[6] = bflo(w.w); v[7] = bfhi(w.w); }
DI float fexp2(float x) { return __builtin_amdgcn_exp2f(x); }
DI float silu_f(float v) { return v / (1.f + __expf(-v)); }
DI float sigm_f(float v) { return 1.f / (1.f + __expf(-v)); }
DI s16x4 trr(unsigned addr) { return __builtin_bit_cast(s16x4, __builtin_amdgcn_ds_read_tr16_b64_v4i16((LAS v4i16_t*)addr)); }
DI bf16x8 cat4(s16x4 lo, s16x4 hi) { return __builtin_shufflevector(lo, hi, 0, 1, 2, 3, 4, 5, 6, 7); }
DI int crow(int reg, int h) { return (reg & 3) + 8 * (reg >> 2) + 4 * h; }
DI bf16x8 packstep(const f32x16& x, int s) { u32x4 p; p.x = cvtpk(x[8 * s], x[8 * s + 1]); p.y = cvtpk(x[8 * s + 2], x[8 * s + 3]); p.z = cvtpk(x[8 * s + 4], x[8 * s + 5]); p.w = cvtpk(x[8 * s + 6], x[8 * s + 7]); return __builtin_bit_cast(bf16x8, p); }
DI float wave_sum(float v) {
#pragma unroll
    for (int o = 1; o < 64; o <<= 1) v += __shfl_xor(v, o);
    return v;
}

template <class F> struct EpiG {
    static constexpr bool PERM = true, AFTER_DRAIN = false;
    F f; int pn_off;
    __device__ __forceinline__ void operator()(const pg8::f32x4 (&acc)[2][2][4][2], const pg8::Unit& u, int wr_, int wc_, int fr_, int fq_) const {
        int t_ = threadIdx.x; asm volatile("" : "+v"(t_));
        const int wid_ = __builtin_amdgcn_readfirstlane(t_ >> 6), wr = wid_ >> 2, wc = wid_ & 3, fr = t_ & 15, fq = (t_ >> 4) & 3;
#pragma unroll
        for (int ai = 0; ai < 2; ++ai)
#pragma unroll
            for (int m = 0; m < 4; ++m) {
                const int row = u.pm * 256 + ai * 128 + wr * 64 + m * 16 + fr;
#pragma unroll
                for (int bj = 0; bj < 2; ++bj) {
                    const int col0 = (u.pn + pn_off) * 256 + bj * 128 + wc * 32 + 8 * fq;
                    float v[8];
#pragma unroll
                    for (int j = 0; j < 4; ++j) { v[j] = acc[ai][bj][m][0][j]; v[4 + j] = acc[ai][bj][m][1][j]; }
                    f(row, col0, v, u.pn + pn_off);
                    asm volatile("" ::: "memory");
                }
            }
    }
};

struct FIn {
    bf16 *RQ, *RK, *RV, *RG, *GR, *GM, *DQ, *DKV, *KR; float* SS; const float* T1; const float* T2;
    DI void rope4(float (&v)[8], const float* cs) const {
        const f32x4 a = *(const f32x4*)cs, b = *(const f32x4*)(cs + 4);
        const float c0 = a[0], s0 = a[1], c1 = a[2], s1 = a[3], c2 = b[0], s2 = b[1], c3 = b[2], s3 = b[3];
        float t;
        t = v[0] * c0 - v[1] * s0; v[1] = v[1] * c0 + v[0] * s0; v[0] = t;
        t = v[2] * c1 - v[3] * s1; v[3] = v[3] * c1 + v[2] * s1; v[2] = t;
        t = v[4] * c2 - v[5] * s2; v[5] = v[5] * c2 + v[4] * s2; v[4] = t;
        t = v[6] * c3 - v[7] * s3; v[7] = v[7] * c3 + v[6] * s3; v[6] = t;
    }
    DI void operator()(int row, int col0, float (&v)[8], int pn) const {
        const bool lat = row < ML;
        if (pn < 4) {
            if (lat) { const int pos = row & (SEQ - 1), i0 = (col0 & 127) >> 1; rope4(v, T1 + ((size_t)pos * 64 + i0) * 2); }
            if (pn < 2) { if (lat) *(u32x4*)(RQ + (size_t)row * 512 + col0) = pack8(v); }
            else {
#pragma unroll
                for (int j = 0; j < 8; ++j) v[j] *= KSCALE;
                *(u32x4*)(RK + (size_t)row * 512 + (col0 - 512)) = pack8(v);
            }
        } else if (pn < 8) {
            *(u32x4*)(RV + (size_t)row * 1024 + (col0 - 1024)) = pack8(v);
        } else if (pn >= 11 && pn < 15) {
            if (lat) {
#pragma unroll
                for (int j = 0; j < 8; ++j) v[j] = silu_f(v[j]);
                *(u32x4*)(RG + (size_t)row * 1024 + (col0 - 2816)) = pack8(v); }
        } else if (pn >= 15) {
            if (lat) {
#pragma unroll
                for (int j = 0; j < 8; ++j) v[j] = sigm_f(v[j]);
                bf16* dst = pn < 19 ? GR + (size_t)row * 1024 + (col0 - 3840) : GM + (size_t)row * 1024 + (col0 - 4864);
                *(u32x4*)dst = pack8(v); }
        } else {
            float s = 0.f;
#pragma unroll
            for (int j = 0; j < 8; ++j) s += v[j] * v[j];
            s += __shfl_xor(s, 16); s += __shfl_xor(s, 32);
            const int c = col0 - 2048;
            if ((threadIdx.x & 63) < 16) SS[(size_t)row * 24 + (c >> 5)] = s;
            if (c < 384) { if (lat) *(u32x4*)(DQ + (size_t)row * 384 + c) = pack8(v); }
            else if (c < 640) { *(u32x4*)(DKV + (size_t)row * 256 + (c - 384)) = pack8(v); }
            else if (c < 672) {
                const int r = c - 640;
                int b, key;
                if (lat) { b = row >> 12; key = CTX + (row & (SEQ - 1)); const int t = row & (SEQ - 1); const int p = (r < 16) ? (t >> 6) : (t & 63); const int i0 = (r & 15) >> 1; rope4(v, T2 + (p * 8 + i0) * 2); }
                else { b = (row - ML) >> 8; key = (row - ML) & 255; }
                *(u32x4*)(KR + ((size_t)b * KEYS + key) * 32 + r) = pack8(v);
            }
        }
    }
};
struct FQ {
    bf16* QM; const float* SS; const float* T2;
    DI void operator()(int row, int col0, float (&v)[8], int) const {
        const f32x4 a = *(const f32x4*)(SS + (size_t)row * 24), b = *(const f32x4*)(SS + (size_t)row * 24 + 4), c = *(const f32x4*)(SS + (size_t)row * 24 + 8);
        const float ss = ((a[0] + a[1]) + (a[2] + a[3])) + ((b[0] + b[1]) + (b[2] + b[3])) + ((c[0] + c[1]) + (c[2] + c[3]));
        const float sc = rsqrtf(ss * (1.f / 384.f) + RMS_EPS) * QSCALE;
#pragma unroll
        for (int j = 0; j < 8; ++j) v[j] *= sc;
        const int h = col0 / 96, d0 = col0 - 96 * h, bb = row >> 12, t = row & (SEQ - 1);
        if (d0 >= 64) {
            const int r = d0 - 64; const int p = (r < 16) ? (t >> 6) : (t & 63); const int i0 = (r & 15) >> 1;
            const float* cs = T2 + (p * 8 + i0) * 2;
            const f32x4 ca = *(const f32x4*)cs, cb = *(const f32x4*)(cs + 4);
            float tt;
            tt = v[0] * ca[0] - v[1] * ca[1]; v[1] = v[1] * ca[0] + v[0] * ca[1]; v[0] = tt;
            tt = v[2] * ca[2] - v[3] * ca[3]; v[3] = v[3] * ca[2] + v[2] * ca[3]; v[2] = tt;
            tt = v[4] * cb[0] - v[5] * cb[1]; v[5] = v[5] * cb[0] + v[4] * cb[1]; v[4] = tt;
            tt = v[6] * cb[2] - v[7] * cb[3]; v[7] = v[7] * cb[2] + v[6] * cb[3]; v[6] = tt;
        }
        *(u32x4*)(QM + ((size_t)(bb * 8 + h) * SEQ + t) * 96 + d0) = pack8(v);
    }
};
struct FKV {
    bf16 *KN, *VN; const float* SS;
    DI void operator()(int row, int col0, float (&v)[8], int) const {
        const f32x4 a = *(const f32x4*)(SS + (size_t)row * 24 + 12), b = *(const f32x4*)(SS + (size_t)row * 24 + 16);
        const float ss = ((a[0] + a[1]) + (a[2] + a[3])) + ((b[0] + b[1]) + (b[2] + b[3]));
        const float sc = rsqrtf(ss * (1.f / 256.f) + RMS_EPS);
#pragma unroll
        for (int j = 0; j < 8; ++j) v[j] *= sc;
        int bb, key;
        if (row < ML) { bb = row >> 12; key = CTX + (row & (SEQ - 1)); } else { bb = (row - ML) >> 8; key = (row - ML) & 255; }
        const int h = col0 >> 7, r = col0 & 127;
        bf16* dst = (r < 64) ? KN + ((size_t)(bb * 8 + h) * KEYS + key) * 64 + r : VN + ((size_t)(bb * 8 + h) * KEYS + key) * 64 + (r - 64);
        *(u32x4*)dst = pack8(v);
    }
};
struct F5a { float* T; const bf16* GR;
    DI void operator()(int row, int col0, float (&v)[8], int) const {
        float g[8]; unpack8(*(const u32x4*)(GR + (size_t)row * 1024 + col0), g);
        f32x4 o0, o1;
#pragma unroll
        for (int j = 0; j < 4; ++j) { o0[j] = g[j] * v[j]; o1[j] = g[4 + j] * v[4 + j]; }
        *(f32x4*)(T + (size_t)row * 1024 + col0) = o0; *(f32x4*)(T + (size_t)row * 1024 + col0 + 4) = o1;
    } };
struct F5b { const float* T; const bf16* GM; bf16* O;
    DI void operator()(int row, int col0, float (&v)[8], int) const {
        float g[8]; unpack8(*(const u32x4*)(GM + (size_t)row * 1024 + col0), g);
        const f32x4 t0 = *(const f32x4*)(T + (size_t)row * 1024 + col0), t1 = *(const f32x4*)(T + (size_t)row * 1024 + col0 + 4);
        float o[8];
#pragma unroll
        for (int j = 0; j < 4; ++j) { o[j] = t0[j] + g[j] * v[j]; o[4 + j] = t1[j] + g[4 + j] * v[4 + j]; }
        *(u32x4*)(O + (size_t)row * 1024 + col0) = pack8(o);
    } };
struct FRes { const float* base; const float* gate  ; float* O;
    DI void operator()(int row, int col0, float (&v)[8], int) const {
        const int bb = row >> 12;
        const f32x4 x0 = *(const f32x4*)(base + (size_t)row * 1024 + col0), x1 = *(const f32x4*)(base + (size_t)row * 1024 + col0 + 4);
        const f32x4 g0 = *(const f32x4*)(gate + bb * 6144 + col0), g1 = *(const f32x4*)(gate + bb * 6144 + col0 + 4);
        f32x4 o0, o1;
#pragma unroll
        for (int j = 0; j < 4; ++j) { o0[j] = ALPHA * x0[j] + g0[j] * v[j]; o1[j] = ALPHA * x1[j] + g1[j] * v[4 + j]; }
        *(f32x4*)(O + (size_t)row * 1024 + col0) = o0; *(f32x4*)(O + (size_t)row * 1024 + col0 + 4) = o1;
    } };
struct FGU { bf16* H;
    DI void operator()(int row, int col0, float (&v)[8], int) const {
        u32x2 w; w.x = cvtpk(silu_f(v[0]) * v[1], silu_f(v[2]) * v[3]); w.y = cvtpk(silu_f(v[4]) * v[5], silu_f(v[6]) * v[7]);
        *(u32x2*)(H + (size_t)row * DFF + (col0 >> 1)) = w;
    } };

DI int mapcol(int kind, int p) {
    switch (kind) {
    case 0: {
        if (p < 1024) { const int base = (p < 512) ? 0 : 512; const int q = p - base; const int h = q >> 7, r = q & 127; return base + h * 128 + (r >> 1) + 64 * (r & 1); }
        if (p < 2048) return p;
        if (p < 2816) { const int c = p - 2048;
            if (c < 384) return 3072 + c;
            if (c < 640) return 3456 + (c - 384);
            if (c < 672) { const int r = c - 640; const int g = r >> 4, rr = r & 15; return 3712 + 16 * g + (rr >> 1) + 8 * (rr & 1); }
            return -1; }
        if (p < 3840) return 2048 + (p - 2816);
        if (p < 4864) return 3744 + (p - 3840);
        return 4768 + (p - 4864);
        return -1; }
    case 1: return (p & 1) * DFF + (p >> 1);
    case 2: {
        const int h = p / 96, d = p - 96 * h; if (d < 64) return p; const int r = d - 64; const int g = r >> 4, rr = r & 15; return h * 96 + 64 + 16 * g + (rr >> 1) + 8 * (rr & 1); }
    default: return p;
    }
}
DI void tr_item(const float* W, int Nsrc, int K, bf16* WT, const float* rowscale, LAS float* scr, int item, int nblk, int lane, int kind) {
    const int kb = item / nblk, nb = item - kb * nblk, k0 = 64 * kb, n0 = 32 * nb;
    const int src = mapcol(kind, n0 + (lane & 31));
#pragma unroll 8
    for (int i = 0; i < 32; ++i) { const int kk = 2 * i + (lane >> 5); float v = (src >= 0) ? W[(size_t)(k0 + kk) * Nsrc + src] : 0.f; if (rowscale) v *= rowscale[k0 + kk]; scr[kk * 33 + (lane & 31)] = v; }
    asm volatile("s_waitcnt lgkmcnt(0)" ::: "memory");
    const int c = lane & 7;
#pragma unroll
    for (int j = 0; j < 4; ++j) { const int n = (lane >> 3) + 8 * j; const LAS float* s = scr + (8 * c) * 33 + n;
        u32x4 o; o.x = cvtpk(s[0 * 33], s[1 * 33]); o.y = cvtpk(s[2 * 33], s[3 * 33]); o.z = cvtpk(s[4 * 33], s[5 * 33]); o.w = cvtpk(s[6 * 33], s[7 * 33]);
        *(u32x4*)(WT + (size_t)(n0 + n) * K + k0 + 8 * c) = o; }
    asm volatile("s_waitcnt lgkmcnt(0)" ::: "memory");
}
DI void phase0(const Params& p, LAS unsigned char* lds) {
    int tid_ = threadIdx.x; asm volatile("" : "+v"(tid_));
    int G_ = gridDim.x, bx_ = blockIdx.x; asm volatile("" : "+s"(G_), "+s"(bx_));
    const int tid = tid_, lane = tid & 63, wave = tid >> 6, G = G_;
    unsigned char* ws = p.ws;
    {
        LAS float* sm = (LAS float*)lds; LAS float* part = sm + 5120;
        for (int cgp = bx_; cgp < 192; cgp += G) {
            for (int i = tid; i < 5120; i += 512) { const float v = (i < 4096) ? p.c[i] : p.c_ctx[i - 4096]; sm[i] = v / (1.f + expf(-v)); }
            __syncthreads();
            const int cq = tid & 7, ks = tid >> 3, col = cgp * 32 + cq * 4;
            float acc[5][4];
#pragma unroll
            for (int r = 0; r < 5; ++r)
#pragma unroll
                for (int j = 0; j < 4; ++j) acc[r][j] = 0.f;
#pragma unroll 4
            for (int kk = 0; kk < 16; ++kk) { const int k = ks * 16 + kk; const f32x4 w = *(const f32x4*)(p.w_ada + (size_t)k * 6144 + col);
#pragma unroll
                for (int r = 0; r < 5; ++r) { const float s = sm[r * 1024 + k];
#pragma unroll
                    for (int j = 0; j < 4; ++j) acc[r][j] += s * w[j]; } }
#pragma unroll
            for (int r = 0; r < 5; ++r)
#pragma unroll
                for (int j = 0; j < 4; ++j) part[(ks * 5 + r) * 32 + cq * 4 + j] = acc[r][j];
            __syncthreads();
            if (tid < 160) { const int r = tid >> 5, cc = tid & 31; float s = 0.f; for (int k2 = 0; k2 < 64; ++k2) s += part[(k2 * 5 + r) * 32 + cc];
                ((float*)(ws + O_MOD))[r * 6144 + cgp * 32 + cc] = s + p.b_ada[cgp * 32 + cc]; }
            __syncthreads();
        }
    }
    {
        LAS float* scr = (LAS float*)(lds + wave * 8704);
        const int gw = bx_ * 8 + wave, NGW = G * 8;
        constexpr int I0 = 16 * 184, I1 = 16 * 176, I2 = 44 * 32, I3 = 16 * 32, I4 = 16 * 32, I5 = 8 * 32, I6 = 6 * 24, I7 = 4 * 32;
        constexpr int NIT = I0 + I1 + I2 + I3 + I4 + I5 + I6 + I7;
        for (int it = gw; it < NIT; it += NGW) {
            int r = it;
            if (r < I0) { const int nb_ = r % 184; bf16* wt_ = (nb_ < 88) ? (bf16*)(ws + O_WINM) : (bf16*)(ws + O_WING) - (size_t)2816 * 1024; tr_item(p.w_in, INW, 1024, wt_, nullptr, scr, r, 184, lane, 0); continue; } r -= I0;
            if (r < I1) { tr_item(p.w_gu, NGU, 1024, (bf16*)(ws + O_WGU), nullptr, scr, r, 176, lane, 1); continue; } r -= I1;
            if (r < I2) { tr_item(p.w_down, 1024, DFF, (bf16*)(ws + O_WDN), nullptr, scr, r, 32, lane, 9); continue; } r -= I2;
            if (r < I3) { tr_item(p.w_ret_o, 1024, 1024, (bf16*)(ws + O_WRO), nullptr, scr, r, 32, lane, 9); continue; } r -= I3;
            if (r < I4) { tr_item(p.w_out, 1024, 1024, (bf16*)(ws + O_WOUT), nullptr, scr, r, 32, lane, 9); continue; } r -= I4;
            if (r < I5) { tr_item(p.w_mla_o, 1024, 512, (bf16*)(ws + O_WMO), nullptr, scr, r, 32, lane, 9); continue; } r -= I5;
            if (r < I6) { tr_item(p.w_uq, 768, 384, (bf16*)(ws + O_WUQ), p.q_norm, scr, r, 24, lane, 2); continue; } r -= I6;
            tr_item(p.w_ukv, 1024, 256, (bf16*)(ws + O_WUKV), p.kv_norm, scr, r, 32, lane, 9);
        }
    }
    {
        float* T1 = (float*)(ws + O_T1); float* T2 = (float*)(ws + O_T2);
        const int gt = bx_ * 512 + tid, NT = G * 512;
        for (int e = gt; e < 4096 * 64 + 64 * 8; e += NT) {
            float pos, fr; float* dst;
            if (e < 4096 * 64) { pos = (float)(e >> 6); fr = exp2f(-(float)(e & 63) * (13.287712379549449f / 64.f)); dst = T1 + 2 * e; }
            else { const int e2 = e - 4096 * 64; pos = (float)(e2 >> 3); fr = exp2f(-(float)(e2 & 7) * (13.287712379549449f / 8.f)); dst = T2 + 2 * e2; }
            const float ang = pos * fr;
            const double a = (double)ang; const double n = rint(a * 0.15915494309189535); const float rr = (float)(a - n * 6.283185307179586);
            dst[0] = cosf(rr); dst[1] = sinf(rr);
        }
    }
}
DI void phase1(const Params& p) {
    int tid_ = threadIdx.x; asm volatile("" : "+v"(tid_));
    int G_ = gridDim.x, bx_ = blockIdx.x; asm volatile("" : "+s"(G_), "+s"(bx_));
    const int lane = tid_ & 63, gw = bx_ * 8 + (tid_ >> 6), NGW = G_ * 8;
    const float* mod = (const float*)(p.ws + O_MOD);
    bf16* A1 = (bf16*)p.out;
    for (int m = gw; m < MT; m += NGW) {
        const float* xr; const float* md;
        if (m < ML) { xr = p.x + (size_t)m * 1024; md = mod + (m >> 12) * 6144; } else { xr = p.ctx + (size_t)(m - ML) * 1024; md = mod + 4 * 6144; }
#pragma unroll
        for (int j = 0; j < 4; ++j) { const int k = 4 * lane + 256 * j; const f32x4 v = *(const f32x4*)(xr + k), sh = *(const f32x4*)(md + k), sc = *(const f32x4*)(md + 1024 + k);
            u32x2 w; w.x = cvtpk(v[0] * (1.f + sc[0]) + sh[0], v[1] * (1.f + sc[1]) + sh[1]); w.y = cvtpk(v[2] * (1.f + sc[2]) + sh[2], v[3] * (1.f + sc[3]) + sh[3]);
            *(u32x2*)(A1 + (size_t)m * 1024 + k) = w; }
    }
}
DI void ln_pass(const float* V, float* Y, const float* g, const float* bta, bf16* H2, const float* mod) {
    int tid_ = threadIdx.x; asm volatile("" : "+v"(tid_));
    int G_ = gridDim.x, bx_ = blockIdx.x; asm volatile("" : "+s"(G_), "+s"(bx_));
    const int lane = tid_ & 63, gw = bx_ * 8 + (tid_ >> 6), NGW = G_ * 8;
    for (int m = gw; m < ML; m += NGW) {
        f32x4 v[4]; float s = 0.f;
#pragma unroll
        for (int j = 0; j < 4; ++j) { v[j] = *(const f32x4*)(V + (size_t)m * 1024 + 4 * lane + 256 * j); s += (v[j][0] + v[j][1]) + (v[j][2] + v[j][3]); }
        const float mean = wave_sum(s) * (1.f / 1024.f); float s2 = 0.f;
#pragma unroll
        for (int j = 0; j < 4; ++j) { v[j] = v[j] - mean; s2 += (v[j][0] * v[j][0] + v[j][1] * v[j][1]) + (v[j][2] * v[j][2] + v[j][3] * v[j][3]); }
        const float rstd = rsqrtf(wave_sum(s2) * (1.f / 1024.f) + LN_EPS);
        const float* md = mod + (m >> 12) * 6144;
#pragma unroll
        for (int j = 0; j < 4; ++j) { const int k = 4 * lane + 256 * j; const f32x4 gg = *(const f32x4*)(g + k), bb = *(const f32x4*)(bta + k);
            f32x4 y;
#pragma unroll
            for (int e = 0; e < 4; ++e) y[e] = v[j][e] * rstd * gg[e] + bb[e];
            *(f32x4*)(Y + (size_t)m * 1024 + k) = y;
            if (H2) { const f32x4 sh = *(const f32x4*)(md + 3072 + k), sc = *(const f32x4*)(md + 4096 + k);
                u32x2 w; w.x = cvtpk(y[0] * (1.f + sc[0]) + sh[0], y[1] * (1.f + sc[1]) + sh[1]); w.y = cvtpk(y[2] * (1.f + sc[2]) + sh[2], y[3] * (1.f + sc[3]) + sh[3]);
                *(u32x2*)(H2 + (size_t)m * 1024 + k) = w; } }
    }
}

constexpr int SC_KP = 272, SC_VP = 144, SC_K = 0, SC_V = 2 * 128 * SC_KP, SC_ST = SC_V + 2 * 128 * SC_VP, SC_END = SC_ST + 2 * 64 * SC_KP;
static_assert(SC_END <= LDS_BYTES, "scan lds");
DI void scan_item(const Params& p, LAS unsigned char* lds, int item) {
    int tid_ = threadIdx.x; asm volatile("" : "+v"(tid_));
    const int tid = tid_, lane = tid & 63, w = tid >> 6, rb = w >> 1, vb = w & 1, l31 = lane & 31, hh = lane >> 5;
    const int b = item >> 4, h = (item >> 2) & 3, dvs = item & 3;
    const bf16* RQ = (const bf16*)(p.ws + O_RQ); const bf16* RK = (const bf16*)(p.ws + O_RK); const bf16* RV = (const bf16*)(p.ws + O_RV);
    bf16* OC = (bf16*)(p.ws + O_OC);
    const unsigned ldsb = (unsigned)(size_t)lds;
    float lg2[2], gC[2];
    { const float df = p.dec_f[h], db = p.dec_b[h]; lg2[0] = -log1pf(expf(-df)) * 1.4426950408889634f; lg2[1] = -log1pf(expf(-db)) * 1.4426950408889634f; gC[0] = exp2f(lg2[0] * 128.f); gC[1] = exp2f(lg2[1] * 128.f); }
    float vw[2][2];
#pragma unroll
    for (int i = 0; i < 2; ++i) { const int row = (tid >> 3) + 64 * i; vw[0][i] = exp2f(lg2[0] * (float)(127 - row)); vw[1][i] = exp2f(lg2[1] * (float)row); }
    f32x16 S[2];
#pragma unroll
    for (int d = 0; d < 2; ++d)
#pragma unroll
        for (int r = 0; r < 16; ++r) S[d][r] = 0.f;
    u32x4 kst[2][4], vst[2][2];
    auto rowbase = [&](int n, int dir) -> int {
        if (n < 2) return ML + b * CTX + (dir == 0 ? n : 1 - n) * 128;
        return b * SEQ + (dir == 0 ? n - 2 : 33 - n) * 128;
    };
#define SC_ISSUE(n_) do { _Pragma("unroll") for (int dir = 0; dir < 2; ++dir) { const int rb0 = rowbase((n_), dir); \
        _Pragma("unroll") for (int i = 0; i < 4; ++i) { const int id = tid + 512 * i; kst[dir][i] = *(const u32x4*)(RK + (size_t)(rb0 + (id >> 4)) * 512 + h * 128 + (id & 15) * 8); } \
        _Pragma("unroll") for (int i = 0; i < 2; ++i) { const int id = tid + 512 * i; vst[dir][i] = *(const u32x4*)(RV + (size_t)(rb0 + (id >> 3)) * 1024 + h * 256 + dvs * 64 + (id & 7) * 8); } } } while (0)
    SC_ISSUE(0);
    unsigned rmw[16];
#pragma unroll
    for (int r = 0; r < 16; ++r) rmw[r] = 0u;
    const size_t oc_lane = (size_t)(b * SEQ + 32 * rb + 4 * hh) * 1024 + h * 256 + dvs * 64 + 32 * vb + l31;
    for (int n = 0; n < 34; ++n) {
        const bool lat = n >= 2, second = n >= 18;
        bf16x8 qf[8];
        if (lat) { const bf16* q = RQ + (size_t)(rowbase(n, 0) + 32 * rb + l31) * 512 + h * 128 + 8 * hh;
#pragma unroll
            for (int s = 0; s < 8; ++s) qf[s] = *(const bf16x8*)(q + 16 * s); }
#pragma unroll
        for (int dir = 0; dir < 2; ++dir) {
#pragma unroll
            for (int i = 0; i < 4; ++i) { const int id = tid + 512 * i; *(LAS u32x4*)(lds + SC_K + dir * 128 * SC_KP + (id >> 4) * SC_KP + (id & 15) * 16) = kst[dir][i]; }
#pragma unroll
            for (int i = 0; i < 2; ++i) { const int id = tid + 512 * i; float t[8]; unpack8(vst[dir][i], t);
#pragma unroll
                for (int j = 0; j < 8; ++j) t[j] *= vw[dir][i];
                *(LAS u32x4*)(lds + SC_V + dir * 128 * SC_VP + (id >> 3) * SC_VP + (id & 7) * 16) = pack8(t); }
#pragma unroll
            for (int g = 0; g < 4; ++g) { u32x2 wv; wv.x = cvtpk(S[dir][4 * g], S[dir][4 * g + 1]); wv.y = cvtpk(S[dir][4 * g + 2], S[dir][4 * g + 3]);
                *(LAS u32x2*)(lds + SC_ST + dir * 64 * SC_KP + (32 * vb + l31) * SC_KP + (32 * rb + 8 * g + 4 * hh) * 2) = wv; }
        }
        __syncthreads();
#pragma unroll
        for (int dir = 0; dir < 2; ++dir) {
            if (lat) {
                f32x16 o;
#pragma unroll
                for (int r = 0; r < 16; ++r) o[r] = 0.f;
#pragma unroll
                for (int s = 0; s < 8; ++s) { const bf16x8 bfr = *(const LAS bf16x8*)(lds + SC_ST + dir * 64 * SC_KP + (32 * vb + l31) * SC_KP + (16 * s + 8 * hh) * 2); o = MFMA32(qf[s], bfr, o); }
                const int c = (dir == 0) ? n - 2 : 33 - n;
                bf16* dst = OC + oc_lane + (size_t)c * 128 * 1024;
                const float e0 = (dir == 0) ? (float)(32 * rb + 4 * hh + 1) : (float)(128 - 32 * rb - 4 * hh);
#pragma unroll
                for (int r = 0; r < 16; ++r) { const int io = (r & 3) + 8 * (r >> 2);
                    const float sc = fexp2(lg2[dir] * (dir == 0 ? e0 + (float)io : e0 - (float)io));
                    float val = o[r] * sc;
                    if (second) val += bf2f((bf16)rmw[r]);
                    dst[(size_t)io * 1024] = f2bf(val); }
                if (dir == 0) {
                    const bf16* q = RQ + (size_t)(rowbase(n, 1) + 32 * rb + l31) * 512 + h * 128 + 8 * hh;
#pragma unroll
                    for (int s = 0; s < 8; ++s) qf[s] = *(const bf16x8*)(q + 16 * s);
                    if (second) { const bf16* src1 = OC + oc_lane + (size_t)(33 - n) * 128 * 1024;
#pragma unroll
                        for (int r = 0; r < 16; ++r) rmw[r] = src1[(size_t)((r & 3) + 8 * (r >> 2)) * 1024]; }
                }
            }
            if (dir == 0 && n + 1 < 34) SC_ISSUE(n + 1);
#pragma unroll
            for (int r = 0; r < 16; ++r) S[dir][r] *= gC[dir];
            const int q4 = (lane & 15) >> 2, p4 = lane & 3, blk = (lane >> 4) & 1;
            const unsigned ka = ldsb + SC_K + dir * 128 * SC_KP + (8 * hh + q4) * SC_KP + (32 * rb + 16 * blk) * 2 + 8 * p4;
            const unsigned va = ldsb + SC_V + dir * 128 * SC_VP + (8 * hh + q4) * SC_VP + (32 * vb + 16 * blk) * 2 + 8 * p4;
#pragma unroll
            for (int s = 0; s < 8; ++s) {
                const bf16x8 af = cat4(trr(ka + (16 * s) * SC_KP), trr(ka + (16 * s + 4) * SC_KP));
                const bf16x8 bfr = cat4(trr(va + (16 * s) * SC_VP), trr(va + (16 * s + 4) * SC_VP));
                S[dir] = MFMA32(af, bfr, S[dir]);
            }
        }
        if (n + 1 >= 18 && n + 1 < 34) { const bf16* src0 = OC + oc_lane + (size_t)(n - 1) * 128 * 1024;
#pragma unroll
            for (int r = 0; r < 16; ++r) rmw[r] = src0[(size_t)((r & 3) + 8 * (r >> 2)) * 1024]; }
        __syncthreads();
    }
#undef SC_ISSUE
}

constexpr int RO_VP = 528, RO_STAT = 128 * RO_VP;
DI void retout_item(const Params& p, LAS unsigned char* lds, int item) {
    int tid_ = threadIdx.x; asm volatile("" : "+v"(tid_));
    const int tid = tid_, lane = tid & 63, w = tid >> 6, iblk = w & 3, dvh = w >> 2, l31 = lane & 31, hh = lane >> 5;
    const int b = item >> 7, h = (item >> 5) & 3, c = item & 31;
    const bf16* RQ = (const bf16*)(p.ws + O_RQ); const bf16* RK = (const bf16*)(p.ws + O_RK); const bf16* RV = (const bf16*)(p.ws + O_RV);
    const bf16* OC = (const bf16*)(p.ws + O_OC); bf16* RG = (bf16*)(p.ws + O_RG);
    const unsigned ldsb = (unsigned)(size_t)lds;
    const int row0 = b * SEQ + c * 128;
    const float lgf = -log1pf(expf(-p.dec_f[h])) * 1.4426950408889634f, lgb = -log1pf(expf(-p.dec_b[h])) * 1.4426950408889634f;
#pragma unroll
    for (int i = 0; i < 8; ++i) { const int id = tid + 512 * i; const u32x4 v = *(const u32x4*)(RV + (size_t)(row0 + (id >> 5)) * 1024 + h * 256 + (id & 31) * 8);
        *(LAS u32x4*)(lds + (id >> 5) * RO_VP + (id & 31) * 16) = v; }
    bf16x8 qf[8];
    { const bf16* q = RQ + (size_t)(row0 + 32 * iblk + l31) * 512 + h * 128 + 8 * hh;
#pragma unroll
        for (int s = 0; s < 8; ++s) qf[s] = *(const bf16x8*)(q + 16 * s); }
    bf16x8 pf[4][2];
    const int icol = 32 * iblk + l31;
#pragma unroll
    for (int jb = 0; jb < 4; ++jb) {
        f32x16 x;
#pragma unroll
        for (int r = 0; r < 16; ++r) x[r] = 0.f;
        const bf16* kp = RK + (size_t)(row0 + 32 * jb + l31) * 512 + h * 128 + 8 * hh;
#pragma unroll
        for (int s = 0; s < 8; ++s) { const bf16x8 kf = *(const bf16x8*)(kp + 16 * s); x = MFMA32(kf, qf[s], x); }
        if (jb < iblk) {
#pragma unroll
            for (int r = 0; r < 16; ++r) { const int df = icol - (32 * jb + crow(r, hh)); x[r] *= fexp2(lgf * (float)df); }
        } else if (jb > iblk) {
#pragma unroll
            for (int r = 0; r < 16; ++r) { const int df = icol - (32 * jb + crow(r, hh)); x[r] *= fexp2(-lgb * (float)df); }
        } else {
#pragma unroll
            for (int r = 0; r < 16; ++r) { const int df = icol - (32 * jb + crow(r, hh)); const float fd = (float)df;
                const float e = fexp2(fminf(lgf * fd, -lgb * fd)); x[r] *= (df == 0) ? 2.f : e; }
        }
        pf[jb][0] = packstep(x, 0); pf[jb][1] = packstep(x, 1);
    }
    __syncthreads();
    f32x16 ot[4];
    {
        const int q4 = (lane & 15) >> 2, p4 = lane & 3, blk = (lane >> 4) & 1;
#pragma unroll
        for (int dt = 0; dt < 4; ++dt) {
#pragma unroll
            for (int r = 0; r < 16; ++r) ot[dt][r] = 0.f;
            const unsigned va = ldsb + (4 * hh + q4) * RO_VP + (128 * dvh + 32 * dt + 16 * blk) * 2 + 8 * p4;
#pragma unroll
            for (int jb = 0; jb < 4; ++jb)
#pragma unroll
                for (int s = 0; s < 2; ++s) {
                    const bf16x8 af = cat4(trr(va + (32 * jb + 16 * s) * RO_VP), trr(va + (32 * jb + 16 * s + 8) * RO_VP));
                    ot[dt] = MFMA32(af, pf[jb][s], ot[dt]);
                }
        }
    }
    const size_t grow = (size_t)(row0 + icol) * 1024 + h * 256 + 128 * dvh;
    float s1 = 0.f, s2 = 0.f;
#pragma unroll
    for (int dt = 0; dt < 4; ++dt)
#pragma unroll
        for (int g = 0; g < 4; ++g) { const u32x2 ocv = *(const u32x2*)(OC + grow + 32 * dt + 8 * g + 4 * hh);
            ot[dt][4 * g] += bflo(ocv.x); ot[dt][4 * g + 1] += bfhi(ocv.x); ot[dt][4 * g + 2] += bflo(ocv.y); ot[dt][4 * g + 3] += bfhi(ocv.y);
#pragma unroll
            for (int e = 0; e < 4; ++e) { const float t = ot[dt][4 * g + e]; s1 += t; s2 += t * t; } }
    s1 += __shfl_xor(s1, 32); s2 += __shfl_xor(s2, 32);
    LAS float* st = (LAS float*)(lds + RO_STAT);
    if (hh == 0) { st[(dvh * 128 + icol) * 2] = s1; st[(dvh * 128 + icol) * 2 + 1] = s2; }
    __syncthreads();
    const float t1 = st[icol * 2] + st[(128 + icol) * 2], t2 = st[icol * 2 + 1] + st[(128 + icol) * 2 + 1];
    const float mean = t1 * (1.f / 256.f); const float var = fmaxf(t2 * (1.f / 256.f) - mean * mean, 0.f); const float rstd = rsqrtf(var + LN_EPS);
#pragma unroll
    for (int dt = 0; dt < 4; ++dt)
#pragma unroll
        for (int g = 0; g < 4; ++g) { bf16* gp = RG + grow + 32 * dt + 8 * g + 4 * hh; const u32x2 gv = *(const u32x2*)gp;
            u32x2 o; o.x = cvtpk((ot[dt][4 * g] - mean) * rstd * bflo(gv.x), (ot[dt][4 * g + 1] - mean) * rstd * bfhi(gv.x));
            o.y = cvtpk((ot[dt][4 * g + 2] - mean) * rstd * bflo(gv.y), (ot[dt][4 * g + 3] - mean) * rstd * bfhi(gv.y));
            *(u32x2*)gp = o; }
    __syncthreads();
}

constexpr int AT_KP = 208, AT_VP = 144, AT_V = 64 * AT_KP, AT_BUF = AT_V + 64 * AT_VP;
DI void attn_unit(const Params& p, LAS unsigned char* lds, int unit) {
    int tid_ = threadIdx.x; asm volatile("" : "+v"(tid_));
    const int tid = tid_, lane = tid & 63, w = tid >> 6, l31 = lane & 31, hh = lane >> 5;
    const int bh = unit >> 4, qb = unit & 15, b = bh >> 3, h = bh & 7;
    const bf16* QM = (const bf16*)((unsigned char*)p.out + OO_QM); const bf16* KN = (const bf16*)((unsigned char*)p.out + OO_KN); const bf16* VN = (const bf16*)((unsigned char*)p.out + OO_VN); const bf16* KR = (const bf16*)(p.ws + O_KR);
    bf16* AO = (bf16*)(p.ws + O_AO);
    const unsigned ldsb = (unsigned)(size_t)lds;
    bf16x8 qf[6];
    { const bf16* q = QM + ((size_t)bh * SEQ + qb * 256 + 32 * w + l31) * 96 + 8 * hh;
#pragma unroll
        for (int s = 0; s < 6; ++s) qf[s] = *(const bf16x8*)(q + 16 * s); }
    const bf16* kn = KN + (size_t)bh * KEYS * 64 + (size_t)(tid >> 3) * 64 + (tid & 7) * 8;
    const bf16* vn = VN + (size_t)bh * KEYS * 64 + (size_t)(tid >> 3) * 64 + (tid & 7) * 8;
    const bf16* kr = KR + (size_t)b * KEYS * 32 + (size_t)((tid & 255) >> 2) * 32 + (tid & 3) * 8;
    u32x4 sk, sv, sr;
#define AT_ISSUE(t_) do { sk = *(const u32x4*)(kn + (size_t)(t_) * 64 * 64); sv = *(const u32x4*)(vn + (size_t)(t_) * 64 * 64); if (tid < 256) sr = *(const u32x4*)(kr + (size_t)(t_) * 64 * 32); } while (0)
#define AT_WRITE(buf_) do { LAS unsigned char* bb_ = lds + (buf_) * AT_BUF; *(LAS u32x4*)(bb_ + (tid >> 3) * AT_KP + (tid & 7) * 16) = sk; *(LAS u32x4*)(bb_ + AT_V + (tid >> 3) * AT_VP + (tid & 7) * 16) = sv; \
        if (tid < 256) *(LAS u32x4*)(bb_ + (tid >> 2) * AT_KP + 128 + (tid & 3) * 16) = sr; } while (0)
    f32x16 o[2];
#pragma unroll
    for (int d = 0; d < 2; ++d)
#pragma unroll
        for (int r = 0; r < 16; ++r) o[d][r] = 0.f;
    float m = -1e30f, lsum = 0.f;
    AT_ISSUE(0); AT_WRITE(0); AT_ISSUE(1);
    __syncthreads();
    constexpr int NT = KEYS / 64;
    const int q4 = (lane & 15) >> 2, p4 = lane & 3, blk = (lane >> 4) & 1;
    for (int t = 0; t < NT; ++t) {
        const unsigned kb0 = ldsb + (t & 1) * AT_BUF;
        f32x16 x[2];
#pragma unroll
        for (int kb = 0; kb < 2; ++kb) {
#pragma unroll
            for (int r = 0; r < 16; ++r) x[kb][r] = 0.f;
#pragma unroll
            for (int s = 0; s < 6; ++s) { const bf16x8 kf = *(const LAS bf16x8*)(lds + (t & 1) * AT_BUF + (32 * kb + l31) * AT_KP + (16 * s + 8 * hh) * 2); x[kb] = MFMA32(kf, qf[s], x[kb]); }
        }
        float mx = x[0][0];
#pragma unroll
        for (int r = 1; r < 16; ++r) mx = fmaxf(mx, x[0][r]);
#pragma unroll
        for (int r = 0; r < 16; ++r) mx = fmaxf(mx, x[1][r]);
        mx = fmaxf(mx, __shfl_xor(mx, 32));
        const float mn = fmaxf(m, mx), alpha = fexp2(m - mn);
        m = mn;
        float ps = 0.f;
#pragma unroll
        for (int kb = 0; kb < 2; ++kb)
#pragma unroll
            for (int r = 0; r < 16; ++r) { const float e = fexp2(x[kb][r] - mn); x[kb][r] = e; ps += e; }
        lsum = lsum * alpha + ps;
#pragma unroll
        for (int d = 0; d < 2; ++d)
#pragma unroll
            for (int r = 0; r < 16; ++r) o[d][r] *= alpha;
        bf16x8 pf[2][2];
#pragma unroll
        for (int kb = 0; kb < 2; ++kb) { pf[kb][0] = packstep(x[kb], 0); pf[kb][1] = packstep(x[kb], 1); }
#pragma unroll
        for (int dt = 0; dt < 2; ++dt) {
            const unsigned va = kb0 + AT_V + (4 * hh + q4) * AT_VP + (32 * dt + 16 * blk) * 2 + 8 * p4;
#pragma unroll
            for (int kb = 0; kb < 2; ++kb)
#pragma unroll
                for (int s = 0; s < 2; ++s) {
                    const bf16x8 af = cat4(trr(va + (32 * kb + 16 * s) * AT_VP), trr(va + (32 * kb + 16 * s + 8) * AT_VP));
                    o[dt] = MFMA32(af, pf[kb][s], o[dt]);
                }
        }
        if (t + 1 < NT) { AT_WRITE((t + 1) & 1); if (t + 2 < NT) AT_ISSUE(t + 2); }
        __syncthreads();
    }
    const float l = lsum + __shfl_xor(lsum, 32), inv = 1.f / l;
    bf16* dst = AO + (size_t)(b * SEQ + qb * 256 + 32 * w + l31) * 512 + h * 64;
#pragma unroll
    for (int dt = 0; dt < 2; ++dt)
#pragma unroll
        for (int g = 0; g < 4; ++g) { u32x2 wv; wv.x = cvtpk(o[dt][4 * g] * inv, o[dt][4 * g + 1] * inv); wv.y = cvtpk(o[dt][4 * g + 2] * inv, o[dt][4 * g + 3] * inv);
            *(u32x2*)(dst + 32 * dt + 8 * g + 4 * hh) = wv; }
#undef AT_ISSUE
#undef AT_WRITE
}

template <class F> DI void run_gemm(LAS unsigned char* lds, const bf16* A, const bf16* Bt, int M, int N, int K, int G, int c, const F& f, int pn_off = 0) {
    asm volatile("" : "+s"(M), "+s"(N), "+s"(K));
    pg8::Gemm g{A, Bt, M, N, K}; pg8::StaticOrder S; S.init(M, N, G, c);
    EpiG<F> E{f, pn_off};
    pg8::gemm_phase<EpiG<F>, pg8::StaticOrder, true, true>(lds, g, S, E);
}

#define XB_TMO      128
#define XB_XCNT(j)  (256  + 64 * (j))
#define XB_XSUB(j)  (1280 + 64 * (j))
#define XB_XGEN(j)  (2304 + 64 * (j))
#define XB_TOP      3328
#define XB_TOPGEN   3392
#define XCD_BAR_WORDS 3456
#define XB_SPIN_CAP (1u << 18)

__device__ __forceinline__ unsigned xb_ld(unsigned* p)              { return __hip_atomic_load(p, __ATOMIC_RELAXED, __HIP_MEMORY_SCOPE_AGENT); }
__device__ __forceinline__ unsigned xb_add(unsigned* p, unsigned v) { return __hip_atomic_fetch_add(p, v, __ATOMIC_RELAXED, __HIP_MEMORY_SCOPE_AGENT); }
__device__ __forceinline__ unsigned xb_xcc_id() { return (unsigned)__builtin_amdgcn_s_getreg((3 << 11) | 20) & 0xFu; }
#define XB_SPIN(cond, bar) do { unsigned _sp = 0; while (cond) { __builtin_amdgcn_s_sleep(1); \
    if ((++_sp & 255u) == 0u) { if (xb_ld(&(bar)[XB_TMO])) break; if (_sp > XB_SPIN_CAP) { atomicAdd(&(bar)[XB_TMO], 1u); break; } } } } while (0)

struct XcdBarrier {
    unsigned* bar; unsigned x;
    volatile LAS unsigned* st;
};

__device__ __forceinline__ XcdBarrier xcd_barrier_post(unsigned* bar, volatile LAS unsigned* st) {
    XcdBarrier b; b.bar = bar; b.x = xb_xcc_id(); b.st = st;
    if (threadIdx.x == 0) (void)xb_add(&bar[XB_XCNT(b.x)], 1u);
    return b;
}
__device__ __forceinline__ void xcd_barrier_complete(unsigned* bar, unsigned x, unsigned& nloc, unsigned& nx) {
    const unsigned G = gridDim.x * gridDim.y * gridDim.z;
    unsigned sum, cnt, mine, sp = 0u;
    for (;;) {
        sum = 0u; cnt = 0u; mine = 0u;
#pragma unroll
        for (unsigned j = 0; j < 16; ++j) { const unsigned c = xb_ld(&bar[XB_XCNT(j)]); sum += c; cnt += (c > 0u) ? 1u : 0u; mine = (j == x) ? c : mine; }
        if (sum == G) break;
        __builtin_amdgcn_s_sleep(1);
        if ((++sp & 255u) == 0u) { if (xb_ld(&bar[XB_TMO])) break; if (sp > XB_SPIN_CAP) { atomicAdd(&bar[XB_TMO], 1u); break; } }
    }
    nloc = mine > 0u ? mine : 1u; nx = cnt > 0u ? cnt : 1u;
}

__device__ __forceinline__ void xcd_barrier(const XcdBarrier& b) {
    asm volatile("s_waitcnt vmcnt(0)" ::: "memory");
    __syncthreads();
    if (threadIdx.x == 0) {
        unsigned* bar = b.bar;
        __builtin_amdgcn_s_waitcnt(0);
        unsigned nloc = b.st[0], nx = b.st[1];
        if (nloc == 0u) { xcd_barrier_complete(bar, b.x, nloc, nx); b.st[0] = nloc; b.st[1] = nx; }
        const unsigned old = xb_add(&bar[XB_XSUB(b.x)], 1u);
        const unsigned gen = old / nloc;
        if (old + 1u == (gen + 1u) * nloc) {
            __builtin_amdgcn_fence(__ATOMIC_RELEASE, "agent");
            asm volatile("s_waitcnt vmcnt(0)" ::: "memory");
            const unsigned og = xb_add(&bar[XB_TOP], 1u);
            const unsigned tg = og / nx;
            if (og + 1u == (tg + 1u) * nx) xb_add(&bar[XB_TOPGEN], 1u);
            else XB_SPIN(xb_ld(&bar[XB_TOPGEN]) == tg, bar);
            __builtin_amdgcn_fence(__ATOMIC_ACQUIRE, "agent");
            xb_add(&bar[XB_XGEN(b.x)], 1u);
            asm volatile("s_waitcnt vmcnt(0)" ::: "memory");
        } else {
            XB_SPIN(xb_ld(&bar[XB_XGEN(b.x)]) == gen, bar);
            __builtin_amdgcn_fence(__ATOMIC_ACQUIRE, "agent");
            asm volatile("s_waitcnt vmcnt(0)" ::: "memory");
        }
    }
    __syncthreads();
}

constexpr size_t O_CTL = 27 * MiB - 65536;
constexpr int LDS_BARW = LDS_BYTES - 64;
static_assert(O_MISC_END <= O_CTL, "ctl region");
typedef const __attribute__((address_space(4))) Params* KP;
#define PH_BEGIN int G = gridDim.x, bx = blockIdx.x; asm volatile("" : "+s"(G), "+s"(bx)); (void)G; (void)bx; KP q_ = kp; asm volatile("" : "+s"(q_)); const Params p = *q_; unsigned char* ws = p.ws; unsigned char* ob = (unsigned char*)p.out; const float* mod = (const float*)(ws + O_MOD); float* SS = (float*)(ws + O_SS); (void)ob; (void)mod; (void)SS;
#ifndef PH_MASK
#define PH_MASK 0xFFFFFF
#endif
#ifndef REP_MASK
#define REP_MASK 0
#endif
#define NREP(bit) ((REP_MASK & (bit)) ? 2 : 1)
#define XSYNC_ONE() do { KP qb_ = kp; asm volatile("" : "+s"(qb_)); XcdBarrier xb_; xb_.bar = (unsigned*)(qb_->ws + O_CTL); xb_.x = xb_xcc_id(); xb_.st = (volatile LAS unsigned*)(lds + LDS_BARW); xcd_barrier(xb_); } while (0)
#define SYNC() do { XSYNC_ONE(); if (REP_MASK & 0x100000) XSYNC_ONE(); } while (0)
__global__ void __launch_bounds__(512, 2) fwd_kernel(Params p_unused) {
#if defined(__HIP_DEVICE_COMPILE__)
    extern __shared__ __attribute__((aligned(16))) unsigned char lds_raw[];
    LAS unsigned char* lds = (LAS unsigned char*)lds_raw;
    KP kp = (KP)__builtin_amdgcn_kernarg_segment_ptr();
    if (threadIdx.x < 16) ((LAS unsigned*)(lds + LDS_BARW))[threadIdx.x] = 0u;
    __syncthreads();
    (void)xcd_barrier_post((unsigned*)(kp->ws + O_CTL), (volatile LAS unsigned*)(lds + LDS_BARW));

    if (PH_MASK & 1) _Pragma("unroll") for (int rep = 0; rep < NREP(1); ++rep) { PH_BEGIN phase0(p, lds); }
    cg::this_grid().sync();
    if (PH_MASK & 2) _Pragma("unroll") for (int rep = 0; rep < NREP(2); ++rep) { PH_BEGIN phase1(p); }
    SYNC();
    if (PH_MASK & 4) _Pragma("unroll") for (int rep = 0; rep < NREP(4); ++rep) {
        PH_BEGIN
        FIn f{(bf16*)(ws + O_RQ), (bf16*)(ws + O_RK), (bf16*)(ws + O_RV), (bf16*)(ws + O_RG), (bf16*)(ws + O_GR), (bf16*)(ws + O_GM), (bf16*)(ws + O_DQ), (bf16*)(ws + O_DKV), (bf16*)(ws + O_KR), SS,
              (const float*)(ws + O_T1), (const float*)(ws + O_T2)};
        run_gemm(lds, (const bf16*)ob, (const bf16*)(ws + O_WINM), MT, 2816, 1024, G, bx, f);
    }
    SYNC();
    {
        int bq = blockIdx.x; asm volatile("" : "+s"(bq));
        if ((PH_MASK & 8) && bq >= 64) _Pragma("unroll") for (int rep = 0; rep < NREP(8); ++rep) {
            PH_BEGIN
            FIn f{(bf16*)(ws + O_RQ), (bf16*)(ws + O_RK), (bf16*)(ws + O_RV), (bf16*)(ws + O_RG), (bf16*)(ws + O_GR), (bf16*)(ws + O_GM), (bf16*)(ws + O_DQ), (bf16*)(ws + O_DKV), (bf16*)(ws + O_KR), SS,
                  (const float*)(ws + O_T1), (const float*)(ws + O_T2)};
            run_gemm(lds, (const bf16*)ob, (const bf16*)(ws + O_WING), ML, 3072, 1024, G - 64, bx - 64, f, 11);
        } else if ((PH_MASK & 16) && bq < 64) {
            _Pragma("unroll") for (int rep = 0; rep < NREP(16); ++rep) { PH_BEGIN scan_item(p, lds, bx); }
        }
    }
    SYNC();
    if (PH_MASK & 8) {
        { PH_BEGIN FQ fq{(bf16*)(ob + OO_QM), SS, (const float*)(ws + O_T2)};
          run_gemm(lds, (const bf16*)(ws + O_DQ), (const bf16*)(ws + O_WUQ), ML, 768, 384, G, bx, fq); }
        { PH_BEGIN FKV fkv{(bf16*)(ob + OO_KN), (bf16*)(ob + OO_VN), SS};
          run_gemm(lds, (const bf16*)(ws + O_DKV), (const bf16*)(ws + O_WUKV), MT, 1024, 256, G, bx, fkv); }
    }
    SYNC();
    {
        if (PH_MASK & 32) { PH_BEGIN for (int it = bx; it < 512; it += G) retout_item(p, lds, it); }
        if (PH_MASK & 64) _Pragma("unroll") for (int rep = 0; rep < NREP(64); ++rep) { PH_BEGIN for (int u = bx; u < 512; u += G) attn_unit(p, lds, u); }
    }
    SYNC();
    if (PH_MASK & 128) _Pragma("unroll") for (int rep = 0; rep < NREP(128); ++rep) {
        { PH_BEGIN F5a fa{p.out, (const bf16*)(ws + O_GR)};
          run_gemm(lds, (const bf16*)(ws + O_RG), (const bf16*)(ws + O_WRO), ML, 1024, 1024, G, bx, fa); }
        { PH_BEGIN F5b fb{p.out, (const bf16*)(ws + O_GM), (bf16*)(ws + O_GMX)};
          run_gemm(lds, (const bf16*)(ws + O_AO), (const bf16*)(ws + O_WMO), ML, 1024, 512, G, bx, fb); }
    }
    SYNC();
    if (PH_MASK & 256) _Pragma("unroll") for (int rep = 0; rep < NREP(256); ++rep) {
        PH_BEGIN FRes f{p.x, mod + 2048, p.out};
        run_gemm(lds, (const bf16*)(ws + O_GMX), (const bf16*)(ws + O_WOUT), ML, 1024, 1024, G, bx, f);
    }
    SYNC();
    if (PH_MASK & 512) _Pragma("unroll") for (int rep = 0; rep < NREP(512); ++rep) { PH_BEGIN ln_pass(p.out, (float*)(ws + O_X1), p.ln1_g, p.ln1_b, (bf16*)(ws + O_H2), mod); }
    SYNC();
    if (PH_MASK & 1024) _Pragma("unroll") for (int rep = 0; rep < NREP(1024); ++rep) {
        PH_BEGIN FGU f{(bf16*)(ws + O_H)};
        run_gemm(lds, (const bf16*)(ws + O_H2), (const bf16*)(ws + O_WGU), ML, NGU, 1024, G, bx, f);
    }
    SYNC();
    if (PH_MASK & 2048) _Pragma("unroll") for (int rep = 0; rep < NREP(2048); ++rep) {
        PH_BEGIN FRes f{(const float*)(ws + O_X1), mod + 5120, p.out};
        run_gemm(lds, (const bf16*)(ws + O_H), (const bf16*)(ws + O_WDN), ML, 1024, DFF, G, bx, f);
    }
    SYNC();
    if (PH_MASK & 4096) { PH_BEGIN ln_pass(p.out, p.out, p.ln2_g, p.ln2_b, nullptr, mod); }
#endif
}

extern "C" void kernel_launch(void* const* d_in, const int* in_sizes, int n_in, void* d_out, int out_size, void* d_ws, size_t ws_size, hipStream_t stream) {
    static int grid = 0;
    if (grid == 0) {
        if (n_in != 22 || out_size != ML * DM || ws_size < WS_NEED) { fprintf(stderr, "kernel_launch: unexpected shapes (n_in %d out %d ws %zu)\n", n_in, out_size, ws_size); grid = -1; return; }
        int dev = 0, cus = 0, per_cu = 0;
        (void)hipGetDevice(&dev); (void)hipDeviceGetAttribute(&cus, hipDeviceAttributeMultiprocessorCount, dev);
        if (hipFuncSetAttribute((const void*)fwd_kernel, hipFuncAttributeMaxDynamicSharedMemorySize, LDS_BYTES) != hipSuccess) { fprintf(stderr, "kernel_launch: hipFuncSetAttribute failed\n"); grid = -1; return; }
        if (hipOccupancyMaxActiveBlocksPerMultiprocessor(&per_cu, (const void*)fwd_kernel, 512, LDS_BYTES) != hipSuccess || per_cu < 1) { fprintf(stderr, "kernel_launch: occupancy query says %d\n", per_cu); per_cu = 1; }
        (void)hipGetLastError();
        grid = cus;
    }
    if (grid < 0) return;
    if (hipMemsetAsync((char*)d_ws + O_CTL, 0, 16384, stream) != hipSuccess) { fprintf(stderr, "kernel_launch: memset failed\n"); return; }
    Params p{};
    const float** pp = (const float**)&p;
    for (int i = 0; i < 22; ++i) pp[i] = (const float*)d_in[i];
    p.out = (float*)d_out; p.ws = (unsigned char*)d_ws;
    void* args[] = {&p};
    hipError_t e = hipLaunchCooperativeKernel((const void*)fwd_kernel, dim3(grid), dim3(512), args, LDS_BYTES, stream);
    if (e != hipSuccess) fprintf(stderr, "cooperative launch failed: %s (grid %d)\n", hipGetErrorString(e), grid);
}
```

```cpp
#include <hip/hip_runtime.h>
#include <hip/hip_cooperative_groups.h>
#include <cstdio>
#include <cstdint>
namespace cg = cooperative_groups;
#define REP_MASK 0
namespace pg8 {
#define PG8_LAS __attribute__((address_space(3)))
typedef unsigned short bf16_t;
typedef short bf16x8 __attribute__((ext_vector_type(8)));
typedef float f32x4 __attribute__((ext_vector_type(4)));
typedef unsigned u32x4 __attribute__((ext_vector_type(4)));
constexpr int BM = 256, BK = 64, HALF = 128, HTB = HALF * BK * 2  , STAGE_BYTES = 8 * HTB, NXCD = 8, WGM = 8;

__host__ __device__ __forceinline__ int lds_byte(int r, int c) { const int st = (r >> 4) * 2 + (c >> 5), rr = r & 15, cc = c & 31, ob = rr * 64 + cc * 2; return st * 1024 + (ob ^ (((ob >> 9) & 1) << 5)); }
__host__ __device__ __forceinline__ void stage_rc(int b, int& R, int& C) { const int st = b / 1024, sb = b % 1024, swz = sb ^ (((sb >> 9) & 1) << 5); R = (st >> 1) * 16 + swz / 64; C = (st & 1) * 32 + (swz % 64) / 2; }
__host__ __device__ __forceinline__ int perm32(int rho) { const int n = rho >> 4, i = rho & 15; return 8 * (i >> 2) + 4 * n + (i & 3); }

struct Unit { int pm, pn; };
struct Gemm { const bf16_t* A; const bf16_t* Bt; int M, N, K; };

struct StaticOrder {
    int nM, nN, nwg, G, c;
    __host__ __device__ void init(int M, int N, int G_, int c_) { nM = M / BM; nN = N / BM; nwg = nM * nN; G = G_; c = c_; }
    __host__ __device__ bool next(int i, Unit& u) const {
        const long L = (long)i * G + c; if (L >= nwg) return false;
        int wgid = (int)L; { const int q = nwg / NXCD, r = nwg % NXCD, xcd = wgid % NXCD, off = wgid / NXCD; wgid = (xcd < r ? xcd * (q + 1) : r * (q + 1) + (xcd - r) * q) + off; }
        const int nig = WGM * nN, gid = wgid / nig, fm = gid * WGM, gsz = (nM - fm) < WGM ? (nM - fm) : WGM;
        u.pm = fm + ((wgid % nig) % gsz); u.pn = (wgid % nig) / gsz; return true;
    }
    __device__ __forceinline__ void a_ready(const Unit&) const {}
    __device__ __forceinline__ void done(const Unit&) const {}
};

__device__ __forceinline__ unsigned cvt_pk_bf16(float lo, float hi) { unsigned r; asm volatile("v_cvt_pk_bf16_f32 %0, %1, %2" : "=v"(r) : "v"(lo), "v"(hi)); return r; }
typedef float f32x2 __attribute__((ext_vector_type(2)));
template <class Epi, class Sched, bool ALIGN_EPI = false, bool SP2 = false>
__device__ __forceinline__ void gemm_phase(PG8_LAS unsigned char* lds, const Gemm g, const Sched& S, const Epi& E) {
    int tid_l = threadIdx.x; asm volatile("" : "+v"(tid_l));
    const int tid = tid_l, wid = __builtin_amdgcn_readfirstlane(tid >> 6), lane = tid & 63, wr = wid >> 2, wc = wid & 3, fr = lane & 15, fq = lane >> 4;
    const int K = g.K, nt = K / BK;
    unsigned voffA[2], voffB[2];
#pragma unroll
    for (int i = 0; i < 2; ++i) { int R, C; stage_rc(tid * 16 + i * 8192, R, C); const int Rb = Epi::PERM ? ((R & ~31) + perm32(R & 31)) : R;
        voffA[i] = (unsigned)(R * K + C) * 2u; voffB[i] = (unsigned)(Rb * K + C) * 2u; }
    const size_t kstep = (size_t)(BK * 2);
    const size_t hstep = (size_t)HALF * K * 2;
    const size_t tstep = 2 * hstep;
    const unsigned ldsw = (unsigned)wid * 1024u;
    const int aoff = lds_byte(wr * 64 + fr, fq * 8), boff = lds_byte(wc * 32 + fr, fq * 8);
#define PG8_SA(b, h) (((b) * 2 + (h)) * HTB)
#define PG8_SB(b, h) ((4 + (b) * 2 + (h)) * HTB)
#define PG8_STAGE(bufoff, gbase, voff) do { _Pragma("unroll") for (int _i = 0; _i < 2; ++_i) \
        __builtin_amdgcn_global_load_lds((const unsigned*)((const char*)(gbase) + (voff)[_i]), (PG8_LAS unsigned*)(lds + (bufoff) + ldsw + _i * 8192), 16, 0, 0); } while (0)
#define PG8_LDA(dst, b, h) do { _Pragma("unroll") for (int m = 0; m < 4; ++m) _Pragma("unroll") for (int k = 0; k < 2; ++k) dst[m][k] = *(const PG8_LAS bf16x8*)(lds + PG8_SA(b, h) + aoff + m * 2048 + k * 1024); } while (0)
#define PG8_LDB(dst, b, h) do { _Pragma("unroll") for (int n = 0; n < 2; ++n) _Pragma("unroll") for (int k = 0; k < 2; ++k) dst[n][k] = *(const PG8_LAS bf16x8*)(lds + PG8_SB(b, h) + boff + n * 2048 + k * 1024); } while (0)
#define PG8_MMA(ai, bj, At, Bt) do { __builtin_amdgcn_s_setprio(1); _Pragma("unroll") for (int m = 0; m < 4; ++m) _Pragma("unroll") for (int n = 0; n < 2; ++n) _Pragma("unroll") for (int k = 0; k < 2; ++k) \
        acc[ai][bj][m][n] = __builtin_amdgcn_mfma_f32_16x16x32_bf16(Bt[n][k], At[m][k], acc[ai][bj][m][n], 0, 0, 0); __builtin_amdgcn_s_setprio(0); } while (0)
#define PG8_WAIT_V(n) asm volatile("s_waitcnt vmcnt(" #n ")" ::: "memory")
#define PG8_WAIT_L(n) asm volatile("s_waitcnt lgkmcnt(" #n ")" ::: "memory")
#define PG8_BAR __builtin_amdgcn_s_barrier()
#define PG8_SCHED __builtin_amdgcn_sched_barrier(0)
    Unit cur, nxt; int ui = 0;
    if (!S.next(0, cur)) return;
    f32x4 acc[2][2][4][2];
#pragma unroll
    for (int a = 0; a < 2; ++a)
#pragma unroll
        for (int b = 0; b < 2; ++b)
#pragma unroll
            for (int m = 0; m < 4; ++m)
#pragma unroll
                for (int n = 0; n < 2; ++n) acc[a][b][m][n] = (f32x4){0.f, 0.f, 0.f, 0.f};
    bf16x8 At[4][2], B0[2][2], B1[2][2];
    const char* cA = (const char*)g.A + (size_t)cur.pm * tstep; const char* cB = (const char*)g.Bt + (size_t)cur.pn * tstep;
    S.a_ready(cur);
    if constexpr (SP2) {
        PG8_STAGE(PG8_SB(0, 0), cB, voffB); PG8_STAGE(PG8_SB(0, 1), cB + hstep, voffB); PG8_STAGE(PG8_SA(0, 0), cA, voffA); PG8_STAGE(PG8_SA(0, 1), cA + hstep, voffA);
        if (wr == 1) PG8_BAR;
        PG8_WAIT_V(2); PG8_BAR;
        PG8_STAGE(PG8_SB(1, 0), cB + kstep, voffB); PG8_STAGE(PG8_SA(1, 0), cA + kstep, voffA); PG8_STAGE(PG8_SB(1, 1), cB + hstep + kstep, voffB);
        PG8_WAIT_V(6); PG8_BAR;
    } else {
        PG8_STAGE(PG8_SB(0, 0), cB, voffB); PG8_STAGE(PG8_SA(0, 0), cA, voffA); PG8_STAGE(PG8_SB(0, 1), cB + hstep, voffB); PG8_STAGE(PG8_SA(0, 1), cA + hstep, voffA);
        if (wr == 1) PG8_BAR;
        PG8_WAIT_V(4); PG8_BAR;
        PG8_STAGE(PG8_SB(1, 0), cB + kstep, voffB); PG8_STAGE(PG8_SA(1, 0), cA + kstep, voffA); PG8_STAGE(PG8_SB(1, 1), cB + hstep + kstep, voffB);
        PG8_WAIT_V(6); PG8_BAR;
    }
    for (;;) {
        const bool has_next = S.next(ui + 1, nxt);
        const char* nA = has_next ? (const char*)g.A + (size_t)nxt.pm * tstep : cA; const char* nB = has_next ? (const char*)g.Bt + (size_t)nxt.pn * tstep : cB;
        for (int t = 0; t < nt; t += 2) {
            const bool last = (t == nt - 2);
            const char* a1 = cA + (size_t)(t + 1) * kstep;
            const char* a2 = last ? nA : cA + (size_t)(t + 2) * kstep; const char* b2 = last ? nB : cB + (size_t)(t + 2) * kstep;
            const char* a3 = a2 + kstep; const char* b3 = b2 + kstep;
            if (last && has_next) S.a_ready(nxt);
            if constexpr (SP2) {
            PG8_LDB(B0, 0, 0); PG8_LDB(B1, 0, 1); PG8_SCHED; PG8_LDA(At, 0, 0); PG8_STAGE(PG8_SA(1, 1), a1 + hstep, voffA);
            PG8_WAIT_V(8); PG8_WAIT_L(0); PG8_BAR; PG8_MMA(0, 0, At, B0); PG8_MMA(0, 1, At, B1); PG8_BAR; PG8_SCHED;
            PG8_LDA(At, 0, 1); PG8_STAGE(PG8_SB(0, 0), b2, voffB); PG8_STAGE(PG8_SB(0, 1), b2 + hstep, voffB); PG8_STAGE(PG8_SA(0, 0), a2, voffA);
            PG8_WAIT_V(8); PG8_WAIT_L(0); PG8_BAR; PG8_MMA(1, 0, At, B0); PG8_MMA(1, 1, At, B1); PG8_BAR; PG8_SCHED;
            PG8_LDB(B0, 1, 0); PG8_LDB(B1, 1, 1); PG8_SCHED; PG8_LDA(At, 1, 0); PG8_STAGE(PG8_SA(0, 1), a2 + hstep, voffA);
            PG8_WAIT_V(8); PG8_WAIT_L(0); PG8_BAR; PG8_MMA(0, 0, At, B0); PG8_MMA(0, 1, At, B1); PG8_BAR; PG8_SCHED;
            PG8_LDA(At, 1, 1); PG8_STAGE(PG8_SB(1, 0), b3, voffB); PG8_STAGE(PG8_SB(1, 1), b3 + hstep, voffB); PG8_STAGE(PG8_SA(1, 0), a3, voffA);
            PG8_WAIT_V(8); PG8_WAIT_L(0); PG8_BAR; PG8_MMA(1, 0, At, B0); PG8_MMA(1, 1, At, B1); PG8_BAR; PG8_SCHED;
            } else {
            PG8_LDB(B0, 0, 0); PG8_SCHED; PG8_LDA(At, 0, 0); PG8_STAGE(PG8_SA(1, 1), a1 + hstep, voffA);
            PG8_WAIT_L(8); PG8_BAR; PG8_WAIT_L(0); PG8_MMA(0, 0, At, B0); PG8_BAR; PG8_SCHED;
            PG8_LDB(B1, 0, 1); PG8_STAGE(PG8_SB(0, 0), b2, voffB);
            PG8_BAR; PG8_WAIT_L(0); PG8_MMA(0, 1, At, B1); PG8_BAR;
            PG8_LDA(At, 0, 1); PG8_STAGE(PG8_SA(0, 0), a2, voffA);
            PG8_BAR; PG8_WAIT_L(0); PG8_MMA(1, 0, At, B0); PG8_BAR; PG8_SCHED;
            PG8_STAGE(PG8_SB(0, 1), b2 + hstep, voffB);
            PG8_WAIT_V(6); PG8_BAR; PG8_MMA(1, 1, At, B1); PG8_BAR;
            PG8_LDB(B0, 1, 0); PG8_SCHED; PG8_LDA(At, 1, 0); PG8_STAGE(PG8_SA(0, 1), a2 + hstep, voffA);
            PG8_WAIT_L(8); PG8_BAR; PG8_WAIT_L(0); PG8_MMA(0, 0, At, B0); PG8_BAR; PG8_SCHED;
            PG8_LDB(B1, 1, 1); PG8_STAGE(PG8_SB(1, 0), b3, voffB);
            PG8_BAR; PG8_WAIT_L(0); PG8_MMA(0, 1, At, B1); PG8_BAR;
            PG8_LDA(At, 1, 1); PG8_STAGE(PG8_SA(1, 0), a3, voffA);
            PG8_BAR; PG8_WAIT_L(0); PG8_MMA(1, 0, At, B0); PG8_BAR; PG8_SCHED;
            PG8_STAGE(PG8_SB(1, 1), b3 + hstep, voffB);
            PG8_WAIT_V(6); PG8_BAR; PG8_MMA(1, 1, At, B1); PG8_BAR;
            }
        }
        if constexpr (ALIGN_EPI) { if (wr == 0) PG8_BAR; }
        if constexpr (!Epi::AFTER_DRAIN) { E(acc, cur, wr, wc, fr, fq); S.done(cur); }
        if (!has_next) break;
#pragma unroll
        for (int a = 0; a < 2; ++a)
#pragma unroll
            for (int b = 0; b < 2; ++b)
#pragma unroll
                for (int m = 0; m < 4; ++m)
#pragma unroll
                    for (int n = 0; n < 2; ++n) acc[a][b][m][n] = (f32x4){0.f, 0.f, 0.f, 0.f};
        cur = nxt; cA = nA; cB = nB; ++ui;
        if constexpr (ALIGN_EPI) { if (wr == 1) PG8_BAR; }
    }
    PG8_WAIT_V(0);
    if constexpr (!ALIGN_EPI) { if (wr == 0) PG8_BAR; }
    PG8_BAR;
    if constexpr (Epi::AFTER_DRAIN) { E.fused(acc, cur, wr, wc, fr, fq, lds, wid, lane); S.done(cur); }
#undef PG8_SA
#undef PG8_SB
#undef PG8_STAGE
#undef PG8_LDA
#undef PG8_LDB
#undef PG8_MMA
#undef PG8_WAIT_V
#undef PG8_WAIT_L
#undef PG8_BAR
#undef PG8_SCHED
}
}

#define LAS __attribute__((address_space(3)))
#define DI __device__ __forceinline__
typedef unsigned short bf16;
typedef short bf16x8 __attribute__((ext_vector_type(8)));
typedef short s16x4 __attribute__((ext_vector_type(4)));
typedef short v4i16_t __attribute__((ext_vector_type(4)));
typedef float f32x4 __attribute__((ext_vector_type(4)));
typedef float f32x16 __attribute__((ext_vector_type(16)));
typedef unsigned u32x4 __attribute__((ext_vector_type(4)));
typedef unsigned u32x2 __attribute__((ext_vector_type(2)));
typedef float f32x2_t __attribute__((ext_vector_type(2)));
typedef __bf16 bf16x2_t __attribute__((ext_vector_type(2)));
#define MFMA32(a, b, c) __builtin_amdgcn_mfma_f32_32x32x16_bf16((a), (b), (c), 0, 0, 0)

constexpr int DM = 1024, NBAT = 4, SEQ = 4096, CTX = 256, ML = NBAT * SEQ, MC = NBAT * CTX, MT = ML + MC, KEYS = CTX + SEQ;
constexpr int NIN = 5888, INW = 5792, DFF = 2816, NGU = 5632;
constexpr size_t MiB = 1u << 20;
constexpr size_t O_WGU = 0, O_WDN = O_WGU + (size_t)NGU * 1024 * 2, O_WOUT = O_WDN + (size_t)1024 * DFF * 2, O_WRO = O_WOUT + 2 * MiB, O_WMO = O_WRO + 2 * MiB,
                 O_WUQ = O_WMO + 1 * MiB, O_WUKV = O_WUQ + 768 * 384 * 2, O_MOD = O_WUKV + 1024 * 256 * 2, O_T1 = O_MOD + 5 * 6144 * 4, O_T2 = O_T1 + 4096 * 64 * 8,
                 O_SS = O_T2 + 64 * 8 * 8, O_MISC_END = O_SS + (size_t)MT * 24 * 4;
static_assert(O_MISC_END <= 27 * MiB, "misc region");
constexpr size_t O_RQ = 27 * MiB, O_RK = 43 * MiB, O_RV = 60 * MiB, O_RG = 94 * MiB, O_GR = 126 * MiB, O_GM = 158 * MiB, O_DQ = 190 * MiB, O_DKV = 202 * MiB,
                 O_WING = 211 * MiB, O_WINM = 217 * MiB, O_OC = 217 * MiB, O_KR = 254 * MiB, O_AO = 190 * MiB, O_GMX = 27 * MiB, O_X1 = 94 * MiB, O_H2 = 59 * MiB, O_H = 158 * MiB,
                 WS_NEED = 256 * MiB;
constexpr size_t O_QM = 94 * MiB, O_KN = 118 * MiB, O_VN = 135 * MiB;
constexpr size_t OO_OCB = 32 * MiB;
constexpr int LDS_BYTES = 147456;
constexpr float ALPHA = 1.189207115002721f;
constexpr float LN_EPS = 1e-5f, RMS_EPS = 1e-6f;
constexpr float QSCALE = 0.10206207261596575f * 1.4426950408889634f;
constexpr float KSCALE = 0.08838834764831845f;

struct Params {
    const float *x, *c, *ctx, *c_ctx, *w_ada, *b_ada, *w_in, *dec_f, *dec_b, *w_ret_o, *q_norm, *w_uq, *kv_norm, *w_ukv, *w_mla_o, *w_out, *ln1_g, *ln1_b, *w_gu, *w_down, *ln2_g, *ln2_b;
    float* out; unsigned char* ws;
};

DI unsigned cvtpk(float lo, float hi) { f32x2_t v = {lo, hi}; bf16x2_t b = __builtin_convertvector(v, bf16x2_t); return __builtin_bit_cast(unsigned, b); }
DI float bflo(unsigned u) { return __uint_as_float(u << 16); }
DI float bfhi(unsigned u) { return __uint_as_float(u & 0xffff0000u); }
DI float bf2f(bf16 v) { return __uint_as_float(((unsigned)v) << 16); }
DI bf16 f2bf(float f) { return (bf16)(cvtpk(f, 0.f) & 0xffffu); }
DI u32x4 pack8(const float (&v)[8]) { u32x4 w; w.x = cvtpk(v[0], v[1]); w.y = cvtpk(v[2], v[3]); w.z = cvtpk(v[4], v[5]); w.w = cvtpk(v[6], v[7]); return w; }
DI void unpack8(u32x4 w, float (&v)[8]) { v[0] = bflo(w.x); v[1] = bfhi(w.x); v[2] = bflo(w.y); v[3] = bfhi(w.y); v[4] = bflo(w.z); v[5] = bfhi(w.z); v[6] = bflo(w.w); v[7] = bfhi(w.w); }
DI float fexp2(float x) { return __builtin_amdgcn_exp2f(x); }
DI float silu_f(float v) { return v / (1.f + __expf(-v)); }
DI float sigm_f(float v) { return 1.f / (1.f + __expf(-v)); }
DI s16x4 trr(unsigned addr) { return __builtin_bit_cast(s16x4, __builtin_amdgcn_ds_read_tr16_b64_v4i16((LAS v4i16_t*)addr)); }
DI bf16x8 cat4(s16x4 lo, s16x4 hi) { return __builtin_shufflevector(lo, hi, 0, 1, 2, 3, 4, 5, 6, 7); }
DI int crow(int reg, int h) { return (reg & 3) + 8 * (reg >> 2) + 4 * h; }
DI bf16x8 packstep(const f32x16& x, int s) { u32x4 p; p.x = cvtpk(x[8 * s], x[8 * s + 1]); p.y = cvtpk(x[8 * s + 2], x[8 * s + 3]); p.z = cvtpk(x[8 * s + 4], x[8 * s + 5]); p.w = cvtpk(x[8 * s + 6], x[8 * s + 7]); return __builtin_bit_cast(bf16x8, p); }
DI float wave_sum(float v) {
#pragma unroll
    for (int o = 1; o < 64; o <<= 1) v += __shfl_xor(v, o);
    return v;
}

template <class F> struct EpiG {
    static constexpr bool PERM = true, AFTER_DRAIN = false;
    F f; int pn_off;
    __device__ __forceinline__ void operator()(const pg8::f32x4 (&acc)[2][2][4][2], const pg8::Unit& u, int wr_, int wc_, int fr_, int fq_) const {
        int t_ = threadIdx.x; asm volatile("" : "+v"(t_));
        const int wid_ = __builtin_amdgcn_readfirstlane(t_ >> 6), wr = wid_ >> 2, wc = wid_ & 3, fr = t_ & 15, fq = (t_ >> 4) & 3;
#pragma unroll
        for (int ai = 0; ai < 2; ++ai)
#pragma unroll
            for (int m = 0; m < 4; ++m) {
                const int row = u.pm * 256 + ai * 128 + wr * 64 + m * 16 + fr;
#pragma unroll
                for (int bj = 0; bj < 2; ++bj) {
                    const int col0 = (u.pn + pn_off) * 256 + bj * 128 + wc * 32 + 8 * fq;
                    float v[8];
#pragma unroll
                    for (int j = 0; j < 4; ++j) { v[j] = acc[ai][bj][m][0][j]; v[4 + j] = acc[ai][bj][m][1][j]; }
                    f(row, col0, v, u.pn + pn_off);
                    asm volatile("" ::: "memory");
                }
            }
    }
};

struct FIn {
    bf16 *RQ, *RK, *RV, *RG, *GR, *GM, *DQ, *DKV, *KR; float* SS; const float* T1; const float* T2;
    DI void rope4(float (&v)[8], const float* cs) const {
        const f32x4 a = *(const f32x4*)cs, b = *(const f32x4*)(cs + 4);
        const float c0 = a[0], s0 = a[1], c1 = a[2], s1 = a[3], c2 = b[0], s2 = b[1], c3 = b[2], s3 = b[3];
        float t;
        t = v[0] * c0 - v[1] * s0; v[1] = v[1] * c0 + v[0] * s0; v[0] = t;
        t = v[2] * c1 - v[3] * s1; v[3] = v[3] * c1 + v[2] * s1; v[2] = t;
        t = v[4] * c2 - v[5] * s2; v[5] = v[5] * c2 + v[4] * s2; v[4] = t;
        t = v[6] * c3 - v[7] * s3; v[7] = v[7] * c3 + v[6] * s3; v[6] = t;
    }
    DI void operator()(int row, int col0, float (&v)[8], int pn) const {
        const bool lat = row < ML;
        if (pn < 4) {
            if (lat) { const int pos = row & (SEQ - 1), i0 = (col0 & 127) >> 1; rope4(v, T1 + ((size_t)pos * 64 + i0) * 2); }
            if (pn < 2) { if (lat) *(u32x4*)(RQ + (size_t)row * 512 + col0) = pack8(v); }
            else {
#pragma unroll
                for (int j = 0; j < 8; ++j) v[j] *= KSCALE;
                *(u32x4*)(RK + (size_t)row * 512 + (col0 - 512)) = pack8(v);
            }
        } else if (pn < 8) {
            *(u32x4*)(RV + (size_t)row * 1024 + (col0 - 1024)) = pack8(v);
        } else if (pn >= 11 && pn < 15) {
            if (lat) {
#pragma unroll
                for (int j = 0; j < 8; ++j) v[j] = silu_f(v[j]);
                *(u32x4*)(RG + (size_t)row * 1024 + (col0 - 2816)) = pack8(v); }
        } else if (pn >= 15) {
            if (lat) {
#pragma unroll
                for (int j = 0; j < 8; ++j) v[j] = sigm_f(v[j]);
                bf16* dst = pn < 19 ? GR + (size_t)row * 1024 + (col0 - 3840) : GM + (size_t)row * 1024 + (col0 - 4864);
                *(u32x4*)dst = pack8(v); }
        } else {
            float s = 0.f;
#pragma unroll
            for (int j = 0; j < 8; ++j) s += v[j] * v[j];
            s += __shfl_xor(s, 16); s += __shfl_xor(s, 32);
            const int c = col0 - 2048;
            if ((threadIdx.x & 63) < 16) SS[(size_t)row * 24 + (c >> 5)] = s;
            if (c < 384) { if (lat) *(u32x4*)(DQ + (size_t)row * 384 + c) = pack8(v); }
            else if (c < 640) { *(u32x4*)(DKV + (size_t)row * 256 + (c - 384)) = pack8(v); }
            else if (c < 672) {
                const int r = c - 640;
                int b, key;
                if (lat) { b = row >> 12; key = CTX + (row & (SEQ - 1)); const int t = row & (SEQ - 1); const int p = (r < 16) ? (t >> 6) : (t & 63); const int i0 = (r & 15) >> 1; rope4(v, T2 + (p * 8 + i0) * 2); }
                else { b = (row - ML) >> 8; key = (row - ML) & 255; }
                *(u32x4*)(KR + ((size_t)b * KEYS + key) * 32 + r) = pack8(v);
            }
        }
    }
};
struct FQ {
    bf16* QM; const float* SS; const float* T2;
    DI void operator()(int row, int col0, float (&v)[8], int) const {
        const f32x4 a = *(const f32x4*)(SS + (size_t)row * 24), b = *(const f32x4*)(SS + (size_t)row * 24 + 4), c = *(const f32x4*)(SS + (size_t)row * 24 + 8);
        const float ss = ((a[0] + a[1]) + (a[2] + a[3])) + ((b[0] + b[1]) + (b[2] + b[3])) + ((c[0] + c[1]) + (c[2] + c[3]));
        const float sc = rsqrtf(ss * (1.f / 384.f) + RMS_EPS) * QSCALE;
#pragma unroll
        for (int j = 0; j < 8; ++j) v[j] *= sc;
        const int h = col0 / 96, d0 = col0 - 96 * h, bb = row >> 12, t = row & (SEQ - 1);
        if (d0 >= 64) {
            const int r = d0 - 64; const int p = (r < 16) ? (t >> 6) : (t & 63); const int i0 = (r & 15) >> 1;
            const float* cs = T2 + (p * 8 + i0) * 2;
            const f32x4 ca = *(const f32x4*)cs, cb = *(const f32x4*)(cs + 4);
            float tt;
            tt = v[0] * ca[0] - v[1] * ca[1]; v[1] = v[1] * ca[0] + v[0] * ca[1]; v[0] = tt;
            tt = v[2] * ca[2] - v[3] * ca[3]; v[3] = v[3] * ca[2] + v[2] * ca[3]; v[2] = tt;
            tt = v[4] * cb[0] - v[5] * cb[1]; v[5] = v[5] * cb[0] + v[4] * cb[1]; v[4] = tt;
            tt = v[6] * cb[2] - v[7] * cb[3]; v[7] = v[7] * cb[2] + v[6] * cb[3]; v[6] = tt;
        }
        *(u32x4*)(QM + ((size_t)(bb * 8 + h) * SEQ + t) * 96 + d0) = pack8(v);
    }
};
struct FKV {
    bf16 *KN, *VN; const float* SS;
    DI void operator()(int row, int col0, float (&v)[8], int) const {
        const f32x4 a = *(const f32x4*)(SS + (size_t)row * 24 + 12), b = *(const f32x4*)(SS + (size_t)row * 24 + 16);
        const float ss = ((a[0] + a[1]) + (a[2] + a[3])) + ((b[0] + b[1]) + (b[2] + b[3]));
        const float sc = rsqrtf(ss * (1.f / 256.f) + RMS_EPS);
#pragma unroll
        for (int j = 0; j < 8; ++j) v[j] *= sc;
        int bb, key;
        if (row < ML) { bb = row >> 12; key = CTX + (row & (SEQ - 1)); } else { bb = (row - ML) >> 8; key = (row - ML) & 255; }
        const int h = col0 >> 7, r = col0 & 127;
        bf16* dst = (r < 64) ? KN + ((size_t)(bb * 8 + h) * KEYS + key) * 64 + r : VN + ((size_t)(bb * 8 + h) * KEYS + key) * 64 + (r - 64);
        *(u32x4*)dst = pack8(v);
    }
};
struct F5a { float* T; const bf16* GR;
    DI void operator()(int row, int col0, float (&v)[8], int) const {
        float g[8]; unpack8(*(const u32x4*)(GR + (size_t)row * 1024 + col0), g);
        f32x4 o0, o1;
#pragma unroll
        for (int j = 0; j < 4; ++j) { o0[j] = g[j] * v[j]; o1[j] = g[4 + j] * v[4 + j]; }
        *(f32x4*)(T + (size_t)row * 1024 + col0) = o0; *(f32x4*)(T + (size_t)row * 1024 + col0 + 4) = o1;
    } };
struct F5b { const float* T; const bf16* GM; bf16* O;
    DI void operator()(int row, int col0, float (&v)[8], int) const {
        float g[8]; unpack8(*(const u32x4*)(GM + (size_t)row * 1024 + col0), g);
        const f32x4 t0 = *(const f32x4*)(T + (size_t)row * 1024 + col0), t1 = *(const f32x4*)(T + (size_t)row * 1024 + col0 + 4);
        float o[8];
#pragma unroll
        for (int j = 0; j < 4; ++j) { o[j] = t0[j] + g[j] * v[j]; o[4 + j] = t1[j] + g[4 + j] * v[4 + j]; }
        *(u32x4*)(O + (size_t)row * 1024 + col0) = pack8(o);
    } };
struct FRes { const float* base; const float* gate  ; float* O;
    DI void operator()(int row, int col0, float (&v)[8], int) const {
        const int bb = row >> 12;
        const f32x4 x0 = *(const f32x4*)(base + (size_t)row * 1024 + col0), x1 = *(const f32x4*)(base + (size_t)row * 1024 + col0 + 4);
        const f32x4 g0 = *(const f32x4*)(gate + bb * 6144 + col0), g1 = *(const f32x4*)(gate + bb * 6144 + col0 + 4);
        f32x4 o0, o1;
#pragma unroll
        for (int j = 0; j < 4; ++j) { o0[j] = ALPHA * x0[j] + g0[j] * v[j]; o1[j] = ALPHA * x1[j] + g1[j] * v[4 + j]; }
        *(f32x4*)(O + (size_t)row * 1024 + col0) = o0; *(f32x4*)(O + (size_t)row * 1024 + col0 + 4) = o1;
    } };
struct FGU { bf16* H;
    DI void operator()(int row, int col0, float (&v)[8], int) const {
        u32x2 w; w.x = cvtpk(silu_f(v[0]) * v[1], silu_f(v[2]) * v[3]); w.y = cvtpk(silu_f(v[4]) * v[5], silu_f(v[6]) * v[7]);
        *(u32x2*)(H + (size_t)row * DFF + (col0 >> 1)) = w;
    } };

DI int mapcol(int kind, int p) {
    switch (kind) {
    case 0: {
        if (p < 1024) { const int base = (p < 512) ? 0 : 512; const int q = p - base; const int h = q >> 7, r = q & 127; return base + h * 128 + (r >> 1) + 64 * (r & 1); }
        if (p < 2048) return p;
        if (p < 2816) { const int c = p - 2048;
            if (c < 384) return 3072 + c;
            if (c < 640) return 3456 + (c - 384);
            if (c < 672) { const int r = c - 640; const int g = r >> 4, rr = r & 15; return 3712 + 16 * g + (rr >> 1) + 8 * (rr & 1); }
            return -1; }
        if (p < 3840) return 2048 + (p - 2816);
        if (p < 4864) return 3744 + (p - 3840);
        return 4768 + (p - 4864);
        return -1; }
    case 1: return (p & 1) * DFF + (p >> 1);
    case 2: {
        const int h = p / 96, d = p - 96 * h; if (d < 64) return p; const int r = d - 64; const int g = r >> 4, rr = r & 15; return h * 96 + 64 + 16 * g + (rr >> 1) + 8 * (rr & 1); }
    default: return p;
    }
}
DI void tr_item(const float* W, int Nsrc, int K, bf16* WT, const float* rowscale, LAS float* scr, int item, int nblk, int lane, int kind) {
    const int kb = item / nblk, nb = item - kb * nblk, k0 = 64 * kb, n0 = 32 * nb;
    const int src = mapcol(kind, n0 + (lane & 31));
#pragma unroll 8
    for (int i = 0; i < 32; ++i) { const int kk = 2 * i + (lane >> 5); float v = (src >= 0) ? W[(size_t)(k0 + kk) * Nsrc + src] : 0.f; if (rowscale) v *= rowscale[k0 + kk]; scr[kk * 33 + (lane & 31)] = v; }
    asm volatile("s_waitcnt lgkmcnt(0)" ::: "memory");
    const int c = lane & 7;
#pragma unroll
    for (int j = 0; j < 4; ++j) { const int n = (lane >> 3) + 8 * j; const LAS float* s = scr + (8 * c) * 33 + n;
        u32x4 o; o.x = cvtpk(s[0 * 33], s[1 * 33]); o.y = cvtpk(s[2 * 33], s[3 * 33]); o.z = cvtpk(s[4 * 33], s[5 * 33]); o.w = cvtpk(s[6 * 33], s[7 * 33]);
        *(u32x4*)(WT + (size_t)(n0 + n) * K + k0 + 8 * c) = o; }
    asm volatile("s_waitcnt lgkmcnt(0)" ::: "memory");
}
DI void phase0(const Params& p, LAS unsigned char* lds) {
    int tid_ = threadIdx.x; asm volatile("" : "+v"(tid_));
    int G_ = gridDim.x, bx_ = blockIdx.x; asm volatile("" : "+s"(G_), "+s"(bx_));
    const int tid = tid_, lane = tid & 63, wave = tid >> 6, G = G_;
    unsigned char* ws = p.ws;
    {
        LAS float* sm = (LAS float*)lds; LAS float* part = sm + 5120;
        for (int cgp = bx_; cgp < 192; cgp += G) {
            for (int i = tid; i < 5120; i += 512) { const float v = (i < 4096) ? p.c[i] : p.c_ctx[i - 4096]; sm[i] = v / (1.f + expf(-v)); }
            __syncthreads();
            const int cq = tid & 7, ks = tid >> 3, col = cgp * 32 + cq * 4;
            float acc[5][4];
#pragma unroll
            for (int r = 0; r < 5; ++r)
#pragma unroll
                for (int j = 0; j < 4; ++j) acc[r][j] = 0.f;
#pragma unroll 4
            for (int kk = 0; kk < 16; ++kk) { const int k = ks * 16 + kk; const f32x4 w = *(const f32x4*)(p.w_ada + (size_t)k * 6144 + col);
#pragma unroll
                for (int r = 0; r < 5; ++r) { const float s = sm[r * 1024 + k];
#pragma unroll
                    for (int j = 0; j < 4; ++j) acc[r][j] += s * w[j]; } }
#pragma unroll
            for (int r = 0; r < 5; ++r)
#pragma unroll
                for (int j = 0; j < 4; ++j) part[(ks * 5 + r) * 32 + cq * 4 + j] = acc[r][j];
            __syncthreads();
            if (tid < 160) { const int r = tid >> 5, cc = tid & 31; float s = 0.f; for (int k2 = 0; k2 < 64; ++k2) s += part[(k2 * 5 + r) * 32 + cc];
                ((float*)(ws + O_MOD))[r * 6144 + cgp * 32 + cc] = s + p.b_ada[cgp * 32 + cc]; }
            __syncthreads();
        }
    }
    {
        LAS float* scr = (LAS float*)(lds + wave * 8704);
        const int gw = bx_ * 8 + wave, NGW = G * 8;
        constexpr int I0 = 16 * 184, I1 = 16 * 176, I2 = 44 * 32, I3 = 16 * 32, I4 = 16 * 32, I5 = 8 * 32, I6 = 6 * 24, I7 = 4 * 32;
        constexpr int NIT = I0 + I1 + I2 + I3 + I4 + I5 + I6 + I7;
        for (int it = gw; it < NIT; it += NGW) {
            int r = it;
            if (r < I0) { const int nb_ = r % 184; bf16* wt_ = (nb_ < 88) ? (bf16*)(ws + O_WINM) : (bf16*)(ws + O_WING) - (size_t)2816 * 1024; tr_item(p.w_in, INW, 1024, wt_, nullptr, scr, r, 184, lane, 0); continue; } r -= I0;
            if (r < I1) { tr_item(p.w_gu, NGU, 1024, (bf16*)(ws + O_WGU), nullptr, scr, r, 176, lane, 1); continue; } r -= I1;
            if (r < I2) { tr_item(p.w_down, 1024, DFF, (bf16*)(ws + O_WDN), nullptr, scr, r, 32, lane, 9); continue; } r -= I2;
            if (r < I3) { tr_item(p.w_ret_o, 1024, 1024, (bf16*)(ws + O_WRO), nullptr, scr, r, 32, lane, 9); continue; } r -= I3;
            if (r < I4) { tr_item(p.w_out, 1024, 1024, (bf16*)(ws + O_WOUT), nullptr, scr, r, 32, lane, 9); continue; } r -= I4;
            if (r < I5) { tr_item(p.w_mla_o, 1024, 512, (bf16*)(ws + O_WMO), nullptr, scr, r, 32, lane, 9); continue; } r -= I5;
            if (r < I6) { tr_item(p.w_uq, 768, 384, (bf16*)(ws + O_WUQ), p.q_norm, scr, r, 24, lane, 2); continue; } r -= I6;
            tr_item(p.w_ukv, 1024, 256, (bf16*)(ws + O_WUKV), p.kv_norm, scr, r, 32, lane, 9);
        }
    }
    {
        float* T1 = (float*)(ws + O_T1); float* T2 = (float*)(ws + O_T2);
        const int gt = bx_ * 512 + tid, NT = G * 512;
        for (int e = gt; e < 4096 * 64 + 64 * 8; e += NT) {
            float pos, fr; float* dst;
            if (e < 4096 * 64) { pos = (float)(e >> 6); fr = exp2f(-(float)(e & 63) * (13.287712379549449f / 64.f)); dst = T1 + 2 * e; }
            else { const int e2 = e - 4096 * 64; pos = (float)(e2 >> 3); fr = exp2f(-(float)(e2 & 7) * (13.287712379549449f / 8.f)); dst = T2 + 2 * e2; }
            const float ang = pos * fr;
            const double a = (double)ang; const double n = rint(a * 0.15915494309189535); const float rr = (float)(a - n * 6.283185307179586);
            dst[0] = cosf(rr); dst[1] = sinf(rr);
        }
    }
}
DI void phase1(const Params& p) {
    int tid_ = threadIdx.x; asm volatile("" : "+v"(tid_));
    int G_ = gridDim.x, bx_ = blockIdx.x; asm volatile("" : "+s"(G_), "+s"(bx_));
    const int lane = tid_ & 63, gw = bx_ * 8 + (tid_ >> 6), NGW = G_ * 8;
    const float* mod = (const float*)(p.ws + O_MOD);
    bf16* A1 = (bf16*)p.out;
    for (int m = gw; m < MT; m += NGW) {
        const float* xr; const float* md;
        if (m < ML) { xr = p.x + (size_t)m * 1024; md = mod + (m >> 12) * 6144; } else { xr = p.ctx + (size_t)(m - ML) * 1024; md = mod + 4 * 6144; }
#pragma unroll
        for (int j = 0; j < 4; ++j) { const int k = 4 * lane + 256 * j; const f32x4 v = *(const f32x4*)(xr + k), sh = *(const f32x4*)(md + k), sc = *(const f32x4*)(md + 1024 + k);
            u32x2 w; w.x = cvtpk(v[0] * (1.f + sc[0]) + sh[0], v[1] * (1.f + sc[1]) + sh[1]); w.y = cvtpk(v[2] * (1.f + sc[2]) + sh[2], v[3] * (1.f + sc[3]) + sh[3]);
            *(u32x2*)(A1 + (size_t)m * 1024 + k) = w; }
    }
}
DI void ln_pass(const float* V, float* Y, const float* g, const float* bta, bf16* H2, const float* mod) {
    int tid_ = threadIdx.x; asm volatile("" : "+v"(tid_));
    int G_ = gridDim.x, bx_ = blockIdx.x; asm volatile("" : "+s"(G_), "+s"(bx_));
    const int lane = tid_ & 63, gw = bx_ * 8 + (tid_ >> 6), NGW = G_ * 8;
    for (int m = gw; m < ML; m += NGW) {
        f32x4 v[4]; float s = 0.f;
#pragma unroll
        for (int j = 0; j < 4; ++j) { v[j] = *(const f32x4*)(V + (size_t)m * 1024 + 4 * lane + 256 * j); s += (v[j][0] + v[j][1]) + (v[j][2] + v[j][3]); }
        const float mean = wave_sum(s) * (1.f / 1024.f); float s2 = 0.f;
#pragma unroll
        for (int j = 0; j < 4; ++j) { v[j] = v[j] - mean; s2 += (v[j][0] * v[j][0] + v[j][1] * v[j][1]) + (v[j][2] * v[j][2] + v[j][3] * v[j][3]); }
        const float rstd = rsqrtf(wave_sum(s2) * (1.f / 1024.f) + LN_EPS);
        const float* md = mod + (m >> 12) * 6144;
#pragma unroll
        for (int j = 0; j < 4; ++j) { const int k = 4 * lane + 256 * j; const f32x4 gg = *(const f32x4*)(g + k), bb = *(const f32x4*)(bta + k);
            f32x4 y;
#pragma unroll
            for (int e = 0; e < 4; ++e) y[e] = v[j][e] * rstd * gg[e] + bb[e];
            *(f32x4*)(Y + (size_t)m * 1024 + k) = y;
            if (H2) { const f32x4 sh = *(const f32x4*)(md + 3072 + k), sc = *(const f32x4*)(md + 4096 + k);
                u32x2 w; w.x = cvtpk(y[0] * (1.f + sc[0]) + sh[0], y[1] * (1.f + sc[1]) + sh[1]); w.y = cvtpk(y[2] * (1.f + sc[2]) + sh[2], y[3] * (1.f + sc[3]) + sh[3]);
                *(u32x2*)(H2 + (size_t)m * 1024 + k) = w; } }
    }
}

constexpr int SC_KP = 272, SC_VP = 144, SC_K = 0, SC_V = 128 * SC_KP, SC_ST = SC_V + 128 * SC_VP, SC_END = SC_ST + 64 * SC_KP;
static_assert(SC_END <= LDS_BYTES - 64, "scan lds");
DI void scan_item(const Params& p, LAS unsigned char* lds, int item) {
    int tid_ = threadIdx.x; asm volatile("" : "+v"(tid_));
    const int tid = tid_, lane = tid & 63, w = tid >> 6, rb = w >> 1, vb = w & 1, l31 = lane & 31, hh = lane >> 5;
    const int b = item >> 5, h = (item >> 3) & 3, dir = (item >> 2) & 1, dvs = item & 3;
    const bf16* RQ = (const bf16*)(p.ws + O_RQ); const bf16* RK = (const bf16*)(p.ws + O_RK); const bf16* RV = (const bf16*)(p.ws + O_RV);
    bf16* OC = dir == 0 ? (bf16*)(p.ws + O_OC) : (bf16*)((unsigned char*)p.out + OO_OCB);
    const unsigned ldsb = (unsigned)(size_t)lds;
    const float dec = dir == 0 ? p.dec_f[h] : p.dec_b[h];
    const float lg2 = -log1pf(expf(-dec)) * 1.4426950408889634f, gC = exp2f(lg2 * 128.f);
    float vw[2];
#pragma unroll
    for (int i = 0; i < 2; ++i) { const int row = (tid >> 3) + 64 * i; vw[i] = exp2f(lg2 * (float)(dir == 0 ? 127 - row : row)); }
    const float ea = dir == 0 ? (float)(32 * rb + 4 * hh + 1) : (float)(128 - 32 * rb - 4 * hh), es = dir == 0 ? 1.f : -1.f;
    f32x16 S;
#pragma unroll
    for (int r = 0; r < 16; ++r) S[r] = 0.f;
    u32x4 kst[4], vst[2];
    bf16x8 qf[8], qn[8];
#pragma unroll
    for (int s = 0; s < 8; ++s) { qf[s] = (bf16x8){0, 0, 0, 0, 0, 0, 0, 0}; qn[s] = qf[s]; }
    auto rowbase = [&](int n) -> int {
        if (n < 2) return ML + b * CTX + (dir == 0 ? n : 1 - n) * 128;
        return b * SEQ + (dir == 0 ? n - 2 : 33 - n) * 128;
    };
#define SC_ISSUE(n_) do { const int rb0 = rowbase(n_); \
        _Pragma("unroll") for (int i = 0; i < 4; ++i) { const int id = tid + 512 * i; kst[i] = *(const u32x4*)(RK + (size_t)(rb0 + (id >> 4)) * 512 + h * 128 + (id & 15) * 8); } \
        _Pragma("unroll") for (int i = 0; i < 2; ++i) { const int id = tid + 512 * i; vst[i] = *(const u32x4*)(RV + (size_t)(rb0 + (id >> 3)) * 1024 + h * 256 + dvs * 64 + (id & 7) * 8); } \
        if ((n_) >= 2) { const bf16* q_ = RQ + (size_t)(rb0 + 32 * rb + l31) * 512 + h * 128 + 8 * hh; \
            _Pragma("unroll") for (int s = 0; s < 8; ++s) qn[s] = *(const bf16x8*)(q_ + 16 * s); } } while (0)
    SC_ISSUE(0);
    const size_t oc_lane = (size_t)(b * SEQ + 32 * rb + 4 * hh) * 1024 + h * 256 + dvs * 64 + 32 * vb + l31;
    for (int n = 0; n < 34; ++n) {
        const bool lat = n >= 2;
#pragma unroll
        for (int i = 0; i < 4; ++i) { const int id = tid + 512 * i; *(LAS u32x4*)(lds + SC_K + (id >> 4) * SC_KP + (id & 15) * 16) = kst[i]; }
#pragma unroll
        for (int i = 0; i < 2; ++i) { const int id = tid + 512 * i; float t[8]; unpack8(vst[i], t);
#pragma unroll
            for (int j = 0; j < 8; ++j) t[j] *= vw[i];
            *(LAS u32x4*)(lds + SC_V + (id >> 3) * SC_VP + (id & 7) * 16) = pack8(t); }
#pragma unroll
        for (int g = 0; g < 4; ++g) { u32x2 wv; wv.x = cvtpk(S[4 * g], S[4 * g + 1]); wv.y = cvtpk(S[4 * g + 2], S[4 * g + 3]);
            *(LAS u32x2*)(lds + SC_ST + (32 * vb + l31) * SC_KP + (32 * rb + 8 * g + 4 * hh) * 2) = wv; }
#pragma unroll
        for (int s = 0; s < 8; ++s) qf[s] = qn[s];
        __syncthreads();
        if (n + 1 < 34) SC_ISSUE(n + 1);
        if (lat) {
            f32x16 o;
#pragma unroll
            for (int r = 0; r < 16; ++r) o[r] = 0.f;
#pragma unroll
            for (int s = 0; s < 8; ++s) { const bf16x8 bfr = *(const LAS bf16x8*)(lds + SC_ST + (32 * vb + l31) * SC_KP + (16 * s + 8 * hh) * 2); o = MFMA32(qf[s], bfr, o); }
            const int c = (dir == 0) ? n - 2 : 33 - n;
            bf16* dst = OC + oc_lane + (size_t)c * 128 * 1024;
#pragma unroll
            for (int r = 0; r < 16; ++r) { const int io = (r & 3) + 8 * (r >> 2);
                dst[(size_t)io * 1024] = f2bf(o[r] * fexp2(lg2 * (ea + es * (float)io))); }
        }
#pragma unroll
        for (int r = 0; r < 16; ++r) S[r] *= gC;
        {
            const int q4 = (lane & 15) >> 2, p4 = lane & 3, blk = (lane >> 4) & 1;
            const unsigned ka = ldsb + SC_K + (8 * hh + q4) * SC_KP + (32 * rb + 16 * blk) * 2 + 8 * p4;
            const unsigned va = ldsb + SC_V + (8 * hh + q4) * SC_VP + (32 * vb + 16 * blk) * 2 + 8 * p4;
#pragma unroll
            for (int s = 0; s < 8; ++s) {
                const bf16x8 af = cat4(trr(ka + (16 * s) * SC_KP), trr(ka + (16 * s + 4) * SC_KP));
                const bf16x8 bfr = cat4(trr(va + (16 * s) * SC_VP), trr(va + (16 * s + 4) * SC_VP));
                S = MFMA32(af, bfr, S);
            }
        }
        __syncthreads();
    }
#undef SC_ISSUE
}

constexpr int RO_VP = 528, RO_STAT = 128 * RO_VP;
template <bool STORE> DI void retout_item(const Params& p, LAS unsigned char* lds, int item) {
    int tid_ = threadIdx.x; asm volatile("" : "+v"(tid_));
    const int tid = tid_, lane = tid & 63, w = tid >> 6, iblk = w & 3, dvh = w >> 2, l31 = lane & 31, hh = lane >> 5;
    const int b = item >> 7, h = (item >> 5) & 3, c = item & 31;
    const bf16* RQ = (const bf16*)(p.ws + O_RQ); const bf16* RK = (const bf16*)(p.ws + O_RK); const bf16* RV = (const bf16*)(p.ws + O_RV);
    const bf16* OC = (const bf16*)(p.ws + O_OC); const bf16* OCB = (const bf16*)((const unsigned char*)p.out + OO_OCB); bf16* RG = (bf16*)(p.ws + O_RG);
    const unsigned ldsb = (unsigned)(size_t)lds;
    const int row0 = b * SEQ + c * 128;
    const float lgf = -log1pf(expf(-p.dec_f[h])) * 1.4426950408889634f, lgb = -log1pf(expf(-p.dec_b[h])) * 1.4426950408889634f;
#pragma unroll
    for (int i = 0; i < 8; ++i) { const int id = tid + 512 * i; const u32x4 v = *(const u32x4*)(RV + (size_t)(row0 + (id >> 5)) * 1024 + h * 256 + (id & 31) * 8);
        *(LAS u32x4*)(lds + (id >> 5) * RO_VP + (id & 31) * 16) = v; }
    bf16x8 qf[8];
    { const bf16* q = RQ + (size_t)(row0 + 32 * iblk + l31) * 512 + h * 128 + 8 * hh;
#pragma unroll
        for (int s = 0; s < 8; ++s) qf[s] = *(const bf16x8*)(q + 16 * s); }
    bf16x8 pf[4][2];
    const int icol = 32 * iblk + l31;
#pragma unroll
    for (int jb = 0; jb < 4; ++jb) {
        f32x16 x;
#pragma unroll
        for (int r = 0; r < 16; ++r) x[r] = 0.f;
        const bf16* kp = RK + (size_t)(row0 + 32 * jb + l31) * 512 + h * 128 + 8 * hh;
#pragma unroll
        for (int s = 0; s < 8; ++s) { const bf16x8 kf = *(const bf16x8*)(kp + 16 * s); x = MFMA32(kf, qf[s], x); }
        if (jb < iblk) {
#pragma unroll
            for (int r = 0; r < 16; ++r) { const int df = icol - (32 * jb + crow(r, hh)); x[r] *= fexp2(lgf * (float)df); }
        } else if (jb > iblk) {
#pragma unroll
            for (int r = 0; r < 16; ++r) { const int df = icol - (32 * jb + crow(r, hh)); x[r] *= fexp2(-lgb * (float)df); }
        } else {
#pragma unroll
            for (int r = 0; r < 16; ++r) { const int df = icol - (32 * jb + crow(r, hh)); const float fd = (float)df;
                const float e = fexp2(fminf(lgf * fd, -lgb * fd)); x[r] *= (df == 0) ? 2.f : e; }
        }
        pf[jb][0] = packstep(x, 0); pf[jb][1] = packstep(x, 1);
    }
    __syncthreads();
    f32x16 ot[4];
    {
        const int q4 = (lane & 15) >> 2, p4 = lane & 3, blk = (lane >> 4) & 1;
#pragma unroll
        for (int dt = 0; dt < 4; ++dt) {
#pragma unroll
            for (int r = 0; r < 16; ++r) ot[dt][r] = 0.f;
            const unsigned va = ldsb + (4 * hh + q4) * RO_VP + (128 * dvh + 32 * dt + 16 * blk) * 2 + 8 * p4;
#pragma unroll
            for (int jb = 0; jb < 4; ++jb)
#pragma unroll
                for (int s = 0; s < 2; ++s) {
                    const bf16x8 af = cat4(trr(va + (32 * jb + 16 * s) * RO_VP), trr(va + (32 * jb + 16 * s + 8) * RO_VP));
                    ot[dt] = MFMA32(af, pf[jb][s], ot[dt]);
                }
        }
    }
    const size_t grow = (size_t)(row0 + icol) * 1024 + h * 256 + 128 * dvh;
    float s1 = 0.f, s2 = 0.f;
#pragma unroll
    for (int dt = 0; dt < 4; ++dt)
#pragma unroll
        for (int g = 0; g < 4; ++g) { const u32x2 ocv = *(const u32x2*)(OC + grow + 32 * dt + 8 * g + 4 * hh), ocw = *(const u32x2*)(OCB + grow + 32 * dt + 8 * g + 4 * hh);
            ot[dt][4 * g] += bflo(ocv.x) + bflo(ocw.x); ot[dt][4 * g + 1] += bfhi(ocv.x) + bfhi(ocw.x); ot[dt][4 * g + 2] += bflo(ocv.y) + bflo(ocw.y); ot[dt][4 * g + 3] += bfhi(ocv.y) + bfhi(ocw.y);
#pragma unroll
            for (int e = 0; e < 4; ++e) { const float t = ot[dt][4 * g + e]; s1 += t; s2 += t * t; } }
    s1 += __shfl_xor(s1, 32); s2 += __shfl_xor(s2, 32);
    LAS float* st = (LAS float*)(lds + RO_STAT);
    if (hh == 0) { st[(dvh * 128 + icol) * 2] = s1; st[(dvh * 128 + icol) * 2 + 1] = s2; }
    __syncthreads();
    const float t1 = st[icol * 2] + st[(128 + icol) * 2], t2 = st[icol * 2 + 1] + st[(128 + icol) * 2 + 1];
    const float mean = t1 * (1.f / 256.f); const float var = fmaxf(t2 * (1.f / 256.f) - mean * mean, 0.f); const float rstd = rsqrtf(var + LN_EPS);
#pragma unroll
    for (int dt = 0; dt < 4; ++dt)
#pragma unroll
        for (int g = 0; g < 4; ++g) { bf16* gp = RG + grow + 32 * dt + 8 * g + 4 * hh; const u32x2 gv = *(const u32x2*)gp;
            u32x2 o; o.x = cvtpk((ot[dt][4 * g] - mean) * rstd * bflo(gv.x), (ot[dt][4 * g + 1] - mean) * rstd * bfhi(gv.x));
            o.y = cvtpk((ot[dt][4 * g + 2] - mean) * rstd * bflo(gv.y), (ot[dt][4 * g + 3] - mean) * rstd * bfhi(gv.y));
            if (STORE) *(u32x2*)gp = o; else asm volatile("" :: "v"(o.x), "v"(o.y)); }
    __syncthreads();
}

constexpr int AT_KP = 208, AT_VP = 144, AT_V = 64 * AT_KP, AT_BUF = AT_V + 64 * AT_VP;
DI void attn_unit(const Params& p, LAS unsigned char* lds, int unit) {
    int tid_ = threadIdx.x; asm volatile("" : "+v"(tid_));
    const int tid = tid_, lane = tid & 63, w = tid >> 6, l31 = lane & 31, hh = lane >> 5;
    const int bh = unit >> 4, qb = unit & 15, b = bh >> 3, h = bh & 7;
    const bf16* QM = (const bf16*)(p.ws + O_QM); const bf16* KN = (const bf16*)(p.ws + O_KN); const bf16* VN = (const bf16*)(p.ws + O_VN); const bf16* KR = (const bf16*)(p.ws + O_KR);
    bf16* AO = (bf16*)(p.ws + O_AO);
    const unsigned ldsb = (unsigned)(size_t)lds;
    bf16x8 qf[6];
    { const bf16* q = QM + ((size_t)bh * SEQ + qb * 256 + 32 * w + l31) * 96 + 8 * hh;
#pragma unroll
        for (int s = 0; s < 6; ++s) qf[s] = *(const bf16x8*)(q + 16 * s); }
    const bf16* kn = KN + (size_t)bh * KEYS * 64 + (size_t)(tid >> 3) * 64 + (tid & 7) * 8;
    const bf16* vn = VN + (size_t)bh * KEYS * 64 + (size_t)(tid >> 3) * 64 + (tid & 7) * 8;
    const bf16* kr = KR + (size_t)b * KEYS * 32 + (size_t)((tid & 255) >> 2) * 32 + (tid & 3) * 8;
    u32x4 sk, sv, sr;
#define AT_ISSUE(t_) do { sk = *(const u32x4*)(kn + (size_t)(t_) * 64 * 64); sv = *(const u32x4*)(vn + (size_t)(t_) * 64 * 64); if (tid < 256) sr = *(const u32x4*)(kr + (size_t)(t_) * 64 * 32); } while (0)
#define AT_WRITE(buf_) do { LAS unsigned char* bb_ = lds + (buf_) * AT_BUF; *(LAS u32x4*)(bb_ + (tid >> 3) * AT_KP + (tid & 7) * 16) = sk; *(LAS u32x4*)(bb_ + AT_V + (tid >> 3) * AT_VP + (tid & 7) * 16) = sv; \
        if (tid < 256) *(LAS u32x4*)(bb_ + (tid >> 2) * AT_KP + 128 + (tid & 3) * 16) = sr; } while (0)
    f32x16 o[2];
#pragma unroll
    for (int d = 0; d < 2; ++d)
#pragma unroll
        for (int r = 0; r < 16; ++r) o[d][r] = 0.f;
    float m = -1e30f, lsum = 0.f;
    AT_ISSUE(0); AT_WRITE(0); AT_ISSUE(1);
    __syncthreads();
    constexpr int NT = KEYS / 64;
    const int q4 = (lane & 15) >> 2, p4 = lane & 3, blk = (lane >> 4) & 1;
    for (int t = 0; t < NT; ++t) {
        const unsigned kb0 = ldsb + (t & 1) * AT_BUF;
        f32x16 x[2];
#pragma unroll
        for (int kb = 0; kb < 2; ++kb) {
#pragma unroll
            for (int r = 0; r < 16; ++r) x[kb][r] = 0.f;
#pragma unroll
            for (int s = 0; s < 6; ++s) { const bf16x8 kf = *(const LAS bf16x8*)(lds + (t & 1) * AT_BUF + (32 * kb + l31) * AT_KP + (16 * s + 8 * hh) * 2); x[kb] = MFMA32(kf, qf[s], x[kb]); }
        }
        float mx = x[0][0];
#pragma unroll
        for (int r = 1; r < 16; ++r) mx = fmaxf(mx, x[0][r]);
#pragma unroll
        for (int r = 0; r < 16; ++r) mx = fmaxf(mx, x[1][r]);
        mx = fmaxf(mx, __shfl_xor(mx, 32));
        const float mn = fmaxf(m, mx), alpha = fexp2(m - mn);
        m = mn;
        float ps = 0.f;
#pragma unroll
        for (int kb = 0; kb < 2; ++kb)
#pragma unroll
            for (int r = 0; r < 16; ++r) { const float e = fexp2(x[kb][r] - mn); x[kb][r] = e; ps += e; }
        lsum = lsum * alpha + ps;
#pragma unroll
        for (int d = 0; d < 2; ++d)
#pragma unroll
            for (int r = 0; r < 16; ++r) o[d][r] *= alpha;
        bf16x8 pf[2][2];
#pragma unroll
        for (int kb = 0; kb < 2; ++kb) { pf[kb][0] = packstep(x[kb], 0); pf[kb][1] = packstep(x[kb], 1); }
#pragma unroll
        for (int dt = 0; dt < 2; ++dt) {
            const unsigned va = kb0 + AT_V + (4 * hh + q4) * AT_VP + (32 * dt + 16 * blk) * 2 + 8 * p4;
#pragma unroll
            for (int kb = 0; kb < 2; ++kb)
#pragma unroll
                for (int s = 0; s < 2; ++s) {
                    const bf16x8 af = cat4(trr(va + (32 * kb + 16 * s) * AT_VP), trr(va + (32 * kb + 16 * s + 8) * AT_VP));
                    o[dt] = MFMA32(af, pf[kb][s], o[dt]);
                }
        }
        if (t + 1 < NT) { AT_WRITE((t + 1) & 1); if (t + 2 < NT) AT_ISSUE(t + 2); }
        __syncthreads();
    }
    const float l = lsum + __shfl_xor(lsum, 32), inv = 1.f / l;
    bf16* dst = AO + (size_t)(b * SEQ + qb * 256 + 32 * w + l31) * 512 + h * 64;
#pragma unroll
    for (int dt = 0; dt < 2; ++dt)
#pragma unroll
        for (int g = 0; g < 4; ++g) { u32x2 wv; wv.x = cvtpk(o[dt][4 * g] * inv, o[dt][4 * g + 1] * inv); wv.y = cvtpk(o[dt][4 * g + 2] * inv, o[dt][4 * g + 3] * inv);
            *(u32x2*)(dst + 32 * dt + 8 * g + 4 * hh) = wv; }
#undef AT_ISSUE
#undef AT_WRITE
}

template <class F> DI void run_gemm(LAS unsigned char* lds, const bf16* A, const bf16* Bt, int M, int N, int K, int G, int c, const F& f, int pn_off = 0) {
    asm volatile("" : "+s"(M), "+s"(N), "+s"(K));
    pg8::Gemm g{A, Bt, M, N, K}; pg8::StaticOrder S; S.init(M, N, G, c);
    EpiG<F> E{f, pn_off};
    pg8::gemm_phase<EpiG<F>, pg8::StaticOrder, true, true>(lds, g, S, E);
}

#define XB_TMO      128
#define XB_XCNT(j)  (256  + 64 * (j))
#define XB_XSUB(j)  (1280 + 64 * (j))
#define XB_XGEN(j)  (2304 + 64 * (j))
#define XB_TOP      3328
#define XB_TOPGEN   3392
#define XCD_BAR_WORDS 3456
#define XB_SPIN_CAP (1u << 18)

__device__ __forceinline__ unsigned xb_ld(unsigned* p)              { return __hip_atomic_load(p, __ATOMIC_RELAXED, __HIP_MEMORY_SCOPE_AGENT); }
__device__ __forceinline__ unsigned xb_add(unsigned* p, unsigned v) { return __hip_atomic_fetch_add(p, v, __ATOMIC_RELAXED, __HIP_MEMORY_SCOPE_AGENT); }
__device__ __forceinline__ unsigned xb_xcc_id() { return (unsigned)__builtin_amdgcn_s_getreg((3 << 11) | 20) & 0xFu; }
#define XB_SPIN(cond, bar) do { unsigned _sp = 0; while (cond) { __builtin_amdgcn_s_sleep(1); \
    if ((++_sp & 255u) == 0u) { if (xb_ld(&(bar)[XB_TMO])) break; if (_sp > XB_SPIN_CAP) { atomicAdd(&(bar)[XB_TMO], 1u); break; } } } } while (0)

struct XcdBarrier {
    unsigned* bar; unsigned x;
    volatile LAS unsigned* st;
};

__device__ __forceinline__ XcdBarrier xcd_barrier_post(unsigned* bar, volatile LAS unsigned* st) {
    XcdBarrier b; b.bar = bar; b.x = xb_xcc_id(); b.st = st;
    if (threadIdx.x == 0) (void)xb_add(&bar[XB_XCNT(b.x)], 1u);
    return b;
}
__device__ __forceinline__ void xcd_barrier_complete(unsigned* bar, unsigned x, unsigned& nloc, unsigned& nx) {
    const unsigned G = gridDim.x * gridDim.y * gridDim.z;
    unsigned sum, cnt, mine, sp = 0u;
    for (;;) {
        sum = 0u; cnt = 0u; mine = 0u;
#pragma unroll
        for (unsigned j = 0; j < 16; ++j) { const unsigned c = xb_ld(&bar[XB_XCNT(j)]); sum += c; cnt += (c > 0u) ? 1u : 0u; mine = (j == x) ? c : mine; }
        if (sum == G) break;
        __builtin_amdgcn_s_sleep(1);
        if ((++sp & 255u) == 0u) { if (xb_ld(&bar[XB_TMO])) break; if (sp > XB_SPIN_CAP) { atomicAdd(&bar[XB_TMO], 1u); break; } }
    }
    nloc = mine > 0u ? mine : 1u; nx = cnt > 0u ? cnt : 1u;
}

__device__ __forceinline__ void xcd_barrier(const XcdBarrier& b) {
    asm volatile("s_waitcnt vmcnt(0)" ::: "memory");
    __syncthreads();
    if (threadIdx.x == 0) {
        unsigned* bar = b.bar;
        __builtin_amdgcn_s_waitcnt(0);
        unsigned nloc = b.st[0], nx = b.st[1];
        if (nloc == 0u) { xcd_barrier_complete(bar, b.x, nloc, nx); b.st[0] = nloc; b.st[1] = nx; }
        const unsigned old = xb_add(&bar[XB_XSUB(b.x)], 1u);
        const unsigned gen = old / nloc;
        if (old + 1u == (gen + 1u) * nloc) {
            __builtin_amdgcn_fence(__ATOMIC_RELEASE, "agent");
            asm volatile("s_waitcnt vmcnt(0)" ::: "memory");
            const unsigned og = xb_add(&bar[XB_TOP], 1u);
            const unsigned tg = og / nx;
            if (og + 1u == (tg + 1u) * nx) xb_add(&bar[XB_TOPGEN], 1u);
            else XB_SPIN(xb_ld(&bar[XB_TOPGEN]) == tg, bar);
            __builtin_amdgcn_fence(__ATOMIC_ACQUIRE, "agent");
            xb_add(&bar[XB_XGEN(b.x)], 1u);
            asm volatile("s_waitcnt vmcnt(0)" ::: "memory");
        } else {
            XB_SPIN(xb_ld(&bar[XB_XGEN(b.x)]) == gen, bar);
            __builtin_amdgcn_fence(__ATOMIC_ACQUIRE, "agent");
            asm volatile("s_waitcnt vmcnt(0)" ::: "memory");
        }
    }
    __syncthreads();
}

constexpr size_t O_CTL = 27 * MiB - 65536;
constexpr int LDS_BARW = LDS_BYTES - 64;
static_assert(O_MISC_END <= O_CTL, "ctl region");
typedef const __attribute__((address_space(4))) Params* KP;
#define PH_BEGIN int G = gridDim.x, bx = blockIdx.x; asm volatile("" : "+s"(G), "+s"(bx)); (void)G; (void)bx; KP q_ = kp; asm volatile("" : "+s"(q_)); const Params p = *q_; unsigned char* ws = p.ws; unsigned char* ob = (unsigned char*)p.out; const float* mod = (const float*)(ws + O_MOD); float* SS = (float*)(ws + O_SS); (void)ob; (void)mod; (void)SS;
#ifndef PH_MASK
#define PH_MASK 0xFFFFFF
#endif
#ifndef REP_MASK
#define REP_MASK 0
#endif
#define NREP(bit) ((REP_MASK & (bit)) ? 2 : 1)
#define XSYNC_ONE() do { KP qb_ = kp; asm volatile("" : "+s"(qb_)); XcdBarrier xb_; xb_.bar = (unsigned*)(qb_->ws + O_CTL); xb_.x = xb_xcc_id(); xb_.st = (volatile LAS unsigned*)(lds + LDS_BARW); xcd_barrier(xb_); } while (0)
#define SYNC() do { XSYNC_ONE(); if (REP_MASK & 0x100000) XSYNC_ONE(); } while (0)
__global__ void __launch_bounds__(512, 2) fwd_kernel(Params p_unused) {
#if defined(__HIP_DEVICE_COMPILE__)
    extern __shared__ __attribute__((aligned(16))) unsigned char lds_raw[];
    LAS unsigned char* lds = (LAS unsigned char*)lds_raw;
    KP kp = (KP)__builtin_amdgcn_kernarg_segment_ptr();
    if (threadIdx.x < 16) ((LAS unsigned*)(lds + LDS_BARW))[threadIdx.x] = 0u;
    __syncthreads();
    (void)xcd_barrier_post((unsigned*)(kp->ws + O_CTL), (volatile LAS unsigned*)(lds + LDS_BARW));

    if (PH_MASK & 1) _Pragma("unroll") for (int rep = 0; rep < NREP(1); ++rep) { PH_BEGIN phase0(p, lds); __syncthreads(); }
    if (gridDim.x == 0x7fffffffu) cg::this_grid().sync();
    SYNC();
    if (PH_MASK & 2) _Pragma("unroll") for (int rep = 0; rep < NREP(2); ++rep) { PH_BEGIN phase1(p); }
    SYNC();
    if (PH_MASK & 4) _Pragma("unroll") for (int rep = 0; rep < NREP(4); ++rep) {
        PH_BEGIN
        FIn f{(bf16*)(ws + O_RQ), (bf16*)(ws + O_RK), (bf16*)(ws + O_RV), (bf16*)(ws + O_RG), (bf16*)(ws + O_GR), (bf16*)(ws + O_GM), (bf16*)(ws + O_DQ), (bf16*)(ws + O_DKV), (bf16*)(ws + O_KR), SS,
              (const float*)(ws + O_T1), (const float*)(ws + O_T2)};
        run_gemm(lds, (const bf16*)ob, (const bf16*)(ws + O_WINM), MT, 2816, 1024, G, bx, f);
    }
    SYNC();
    if (PH_MASK & 8) _Pragma("unroll") for (int rep = 0; rep < NREP(0x200000); ++rep) {
        { PH_BEGIN FQ fq{(bf16*)(ws + O_QM), SS, (const float*)(ws + O_T2)};
          run_gemm(lds, (const bf16*)(ws + O_DQ), (const bf16*)(ws + O_WUQ), ML, 768, 384, G, bx, fq); }
        { PH_BEGIN FKV fkv{(bf16*)(ws + O_KN), (bf16*)(ws + O_VN), SS};
          run_gemm(lds, (const bf16*)(ws + O_DKV), (const bf16*)(ws + O_WUKV), MT, 1024, 256, G, bx, fkv); }
    }
    SYNC();
    {
        int bq = blockIdx.x; asm volatile("" : "+s"(bq));
        if ((PH_MASK & 16) && bq < 128) _Pragma("unroll") for (int rep = 0; rep < NREP(16); ++rep) { PH_BEGIN scan_item(p, lds, bx); }
        if (PH_MASK & 64) _Pragma("unroll") for (int rep = 0; rep < NREP(64); ++rep) {
            PH_BEGIN
            unsigned* ctr = (unsigned*)(ws + O_CTL) + 3584 + 64 * rep;
            volatile LAS unsigned* qw = (volatile LAS unsigned*)(lds + LDS_BARW + 32);
            for (;;) {
                if (threadIdx.x == 0) qw[0] = __hip_atomic_fetch_add(ctr, 1u, __ATOMIC_RELAXED, __HIP_MEMORY_SCOPE_AGENT);
                __syncthreads();
                const unsigned u = qw[0];
                __syncthreads();
                if (u >= 512u) break;
                attn_unit(p, lds, (int)u);
            }
        }
    }
    SYNC();
    if (PH_MASK & 8) _Pragma("unroll") for (int rep = 0; rep < NREP(8); ++rep) {
        PH_BEGIN
        FIn f{(bf16*)(ws + O_RQ), (bf16*)(ws + O_RK), (bf16*)(ws + O_RV), (bf16*)(ws + O_RG), (bf16*)(ws + O_GR), (bf16*)(ws + O_GM), (bf16*)(ws + O_DQ), (bf16*)(ws + O_DKV), (bf16*)(ws + O_KR), SS,
              (const float*)(ws + O_T1), (const float*)(ws + O_T2)};
        run_gemm(lds, (const bf16*)ob, (const bf16*)(ws + O_WING), ML, 3072, 1024, G, bx, f, 11);
    }
    SYNC();
    {
        if ((PH_MASK & 32) && (REP_MASK & 32)) { PH_BEGIN for (int it = bx; it < 512; it += G) retout_item<false>(p, lds, it); }
        if (PH_MASK & 32) { PH_BEGIN for (int it = bx; it < 512; it += G) retout_item<true>(p, lds, it); }
    }
    SYNC();
    if (PH_MASK & 128) _Pragma("unroll") for (int rep = 0; rep < NREP(128); ++rep) {
        { PH_BEGIN F5a fa{p.out, (const bf16*)(ws + O_GR)};
          run_gemm(lds, (const bf16*)(ws + O_RG), (const bf16*)(ws + O_WRO), ML, 1024, 1024, G, bx, fa); }
        { PH_BEGIN F5b fb{p.out, (const bf16*)(ws + O_GM), (bf16*)(ws + O_GMX)};
          run_gemm(lds, (const bf16*)(ws + O_AO), (const bf16*)(ws + O_WMO), ML, 1024, 512, G, bx, fb); }
    }
    SYNC();
    if (PH_MASK & 256) _Pragma("unroll") for (int rep = 0; rep < NREP(256); ++rep) {
        PH_BEGIN FRes f{p.x, mod + 2048, p.out};
        run_gemm(lds, (const bf16*)(ws + O_GMX), (const bf16*)(ws + O_WOUT), ML, 1024, 1024, G, bx, f);
    }
    SYNC();
    if (PH_MASK & 512) _Pragma("unroll") for (int rep = 0; rep < NREP(512); ++rep) { PH_BEGIN ln_pass(p.out, (float*)(ws + O_X1), p.ln1_g, p.ln1_b, (bf16*)(ws + O_H2), mod); }
    SYNC();
    if (PH_MASK & 1024) _Pragma("unroll") for (int rep = 0; rep < NREP(1024); ++rep) {
        PH_BEGIN FGU f{(bf16*)(ws + O_H)};
        run_gemm(lds, (const bf16*)(ws + O_H2), (const bf16*)(ws + O_WGU), ML, NGU, 1024, G, bx, f);
    }
    SYNC();
    if (PH_MASK & 2048) _Pragma("unroll") for (int rep = 0; rep < NREP(2048); ++rep) {
        PH_BEGIN FRes f{(const float*)(ws + O_X1), mod + 5120, p.out};
        run_gemm(lds, (const bf16*)(ws + O_H), (const bf16*)(ws + O_WDN), ML, 1024, DFF, G, bx, f);
    }
    SYNC();
    if (PH_MASK & 4096) { PH_BEGIN ln_pass(p.out, p.out, p.ln2_g, p.ln2_b, nullptr, mod); }
#endif
}

extern "C" void kernel_launch(void* const* d_in, const int* in_sizes, int n_in, void* d_out, int out_size, void* d_ws, size_t ws_size, hipStream_t stream) {
    static int grid = 0;
    if (grid == 0) {
        if (n_in != 22 || out_size != ML * DM || ws_size < WS_NEED) { fprintf(stderr, "kernel_launch: unexpected shapes (n_in %d out %d ws %zu)\n", n_in, out_size, ws_size); grid = -1; return; }
        int dev = 0, cus = 0, per_cu = 0;
        (void)hipGetDevice(&dev); (void)hipDeviceGetAttribute(&cus, hipDeviceAttributeMultiprocessorCount, dev);
        if (hipFuncSetAttribute((const void*)fwd_kernel, hipFuncAttributeMaxDynamicSharedMemorySize, LDS_BYTES) != hipSuccess) { fprintf(stderr, "kernel_launch: hipFuncSetAttribute failed\n"); grid = -1; return; }
        if (hipOccupancyMaxActiveBlocksPerMultiprocessor(&per_cu, (const void*)fwd_kernel, 512, LDS_BYTES) != hipSuccess || per_cu < 1) { fprintf(stderr, "kernel_launch: occupancy query says %d\n", per_cu); per_cu = 1; }
        (void)hipGetLastError();
        grid = cus;
    }
    if (grid < 0) return;
    if (hipMemsetAsync((char*)d_ws + O_CTL, 0, 16384, stream) != hipSuccess) { fprintf(stderr, "kernel_launch: memset failed\n"); return; }
    Params p{};
    const float** pp = (const float**)&p;
    for (int i = 0; i < 22; ++i) pp[i] = (const float*)d_in[i];
    p.out = (float*)d_out; p.ws = (unsigned char*)d_ws;
    void* args[] = {&p};
    hipError_t e = hipLaunchCooperativeKernel((const void*)fwd_kernel, dim3(grid), dim3(512), args, LDS_BYTES, stream);
    if (e != hipSuccess) fprintf(stderr, "cooperative launch failed: %s (grid %d)\n", hipGetErrorString(e), grid);
}
```
